# Optimizing an MI355X kernel written in HIP

```python
import math
import jax, jax.numpy as jnp
from jax import lax
import numpy as np

D_MODEL = 1024
BATCH = 4
SEQ = 8192
DEPTH = 1

GLA_HEADS = 4
GLA_DK = D_MODEL // 16
GLA_DV = D_MODEL // 8
GLA_LOWRANK = 16
GLA_TAU = 16.0
GLA_CHUNK = 64
MOBA_HEADS = 4
MOBA_DH = 128
MOBA_BLOCK = 256
MOBA_TOPK = 3
MOBA_QCHUNK = 32
NUM_BUCKETS = 32
MAX_DISTANCE = 128
MAX_EXACT = NUM_BUCKETS // 2
D_FF = 2816
FFN_RES = 0.5
EPS = 1e-6
N_MOD = 9
GLA_QK_W = GLA_HEADS * GLA_DK
GLA_V_W = GLA_HEADS * GLA_DV
MOBA_W = MOBA_HEADS * MOBA_DH
IN_SIZES = (GLA_QK_W, GLA_QK_W, GLA_V_W, GLA_LOWRANK, GLA_V_W, MOBA_W, MOBA_W, MOBA_W, D_MODEL, D_MODEL)
IN_WIDTH = sum(IN_SIZES)

kernel_name = "hybrid_gla_moba_macaron_adaln"


def rmsnorm(x, g):
    xf = x.astype(jnp.float32)
    y = xf * lax.rsqrt(jnp.mean(xf * xf, axis=-1, keepdims=True) + EPS) * g.astype(jnp.float32)
    return y.astype(x.dtype)


def modulate(x, shift, scale):
    return x * (1.0 + scale[:, None, :]) + shift[:, None, :]


def swiglu(x, w_gate, w_up, w_down):
    return (jax.nn.silu(x @ w_gate) * (x @ w_up)) @ w_down


def rel_bucket(dist):
    n = jnp.maximum(dist, 0)
    nf = jnp.maximum(n, 1).astype(jnp.float32)
    large = MAX_EXACT + (jnp.log(nf / MAX_EXACT) / math.log(MAX_DISTANCE / MAX_EXACT)
                         * (NUM_BUCKETS - MAX_EXACT)).astype(jnp.int32)
    large = jnp.minimum(large, NUM_BUCKETS - 1)
    return jnp.where(n < MAX_EXACT, n, large)


def gla_chunked(q, k, v, log_a):
    B, H, S, dk = q.shape
    dv = v.shape[-1]
    nc = S // GLA_CHUNK

    def to_chunks(t):
        return jnp.moveaxis(t.astype(jnp.float32).reshape(B, H, nc, GLA_CHUNK, t.shape[-1]), 2, 0)

    causal = jnp.tril(jnp.ones((GLA_CHUNK, GLA_CHUNK), dtype=bool))

    def step(state, inp):
        qc, kc, vc, gc = inp
        b = jnp.cumsum(gc, axis=2)
        o_inter = jnp.einsum('bhcd,bhde->bhce', qc * jnp.exp(b), state)
        diff = b[:, :, :, None, :] - b[:, :, None, :, :]
        decay = jnp.exp(jnp.where(causal[:, :, None], diff, -jnp.inf))
        attn = jnp.einsum('bhid,bhijd,bhjd->bhij', qc, decay, kc)
        o = o_inter + jnp.einsum('bhij,bhje->bhie', attn, vc)
        b_last = b[:, :, -1:, :]
        state = (jnp.exp(b_last[:, :, 0, :])[..., None] * state
                 + jnp.einsum('bhcd,bhce->bhde', kc * jnp.exp(b_last - b), vc))
        return state, o

    state0 = jnp.zeros((B, H, dk, dv), jnp.float32)
    _, o = lax.scan(step, state0, (to_chunks(q), to_chunks(k), to_chunks(v), to_chunks(log_a)))
    return jnp.moveaxis(o, 0, 2).reshape(B, H, S, dv)


def moba_attention(q, k, v, rel_bias):
    B, H, S, dh = q.shape
    nb = -(-S // MOBA_BLOCK)
    s_pad = nb * MOBA_BLOCK
    pad = ((0, 0), (0, 0), (0, s_pad - S), (0, 0))
    q = q.astype(jnp.float32)
    k = jnp.pad(k.astype(jnp.float32), pad)
    v = jnp.pad(v.astype(jnp.float32), pad)
    k_blocks = k.reshape(B, H, nb, MOBA_BLOCK, dh)
    v_blocks = v.reshape(B, H, nb, MOBA_BLOCK, dh)
    k_mean = jnp.mean(k_blocks, axis=3)
    topk = min(MOBA_TOPK, nb)
    scale = dh ** -0.5
    head_ix = jnp.arange(H)[None, :, None, None, None]
    gather = jax.vmap(jax.vmap(lambda blocks, ix: blocks[ix]))

    def chunk(ci):
        start = ci * MOBA_QCHUNK
        q_c = lax.dynamic_slice_in_dim(q, start, MOBA_QCHUNK, axis=2)
        q_pos = start + jnp.arange(MOBA_QCHUNK)
        cur = start // MOBA_BLOCK
        gate = jnp.einsum('bhqd,bhnd->bhqn', q_c, k_mean)
        gate = jnp.where(jnp.arange(nb) < cur, gate, -jnp.inf)
        _, sel = lax.top_k(gate, topk)
        sel_valid = jnp.arange(topk) < cur
        k_sel = gather(k_blocks, sel)
        v_sel = gather(v_blocks, sel)
        sel_pos = sel[..., None] * MOBA_BLOCK + jnp.arange(MOBA_BLOCK)
        sel_bias = rel_bias[head_ix, rel_bucket(q_pos[:, None, None] - sel_pos)]
        s_sel = jnp.einsum('bhqd,bhqrkd->bhqrk', q_c, k_sel) * scale + sel_bias
        s_sel = jnp.where(sel_valid[:, None], s_sel, -jnp.inf)
        own_start = cur * MOBA_BLOCK
        k_own = lax.dynamic_slice_in_dim(k, own_start, MOBA_BLOCK, axis=2)
        v_own = lax.dynamic_slice_in_dim(v, own_start, MOBA_BLOCK, axis=2)
        rel = q_pos[:, None] - (own_start + jnp.arange(MOBA_BLOCK))[None, :]
        s_own = jnp.einsum('bhqd,bhkd->bhqk', q_c, k_own) * scale + rel_bias[:, rel_bucket(rel)]
        s_own = jnp.where(rel >= 0, s_own, -jnp.inf)
        n_sel = topk * MOBA_BLOCK
        logits = jnp.concatenate([s_sel.reshape(B, H, MOBA_QCHUNK, n_sel), s_own], axis=-1)
        p = jax.nn.softmax(logits, axis=-1)
        p_sel = p[..., :n_sel].reshape(B, H, MOBA_QCHUNK, topk, MOBA_BLOCK)
        p_own = p[..., n_sel:]
        return (jnp.einsum('bhqrk,bhqrkd->bhqd', p_sel, v_sel)
                + jnp.einsum('bhqk,bhkd->bhqd', p_own, v_own))

    out = lax.map(chunk, jnp.arange(S // MOBA_QCHUNK))
    return jnp.transpose(out, (1, 2, 0, 3, 4)).reshape(B, H, S, dh)


def token_mixing(u, w_in, w_gla_lr, b_gla_lr, gla_norm, rel_bias, w_br_gla, w_br_moba, w_out):
    B, S, _ = u.shape
    proj = u @ w_in
    offsets = np.cumsum(IN_SIZES)[:-1].tolist()
    gq, gk, gv, glr, gog, mq, mk, mv, ga, gb = jnp.split(proj, offsets, axis=-1)

    def heads(t, n):
        return t.reshape(B, S, n, -1).transpose(0, 2, 1, 3)

    log_a = jax.nn.log_sigmoid((glr @ w_gla_lr + b_gla_lr).astype(jnp.float32)) / GLA_TAU
    o_a = gla_chunked(heads(gq, GLA_HEADS) * (GLA_DK ** -0.5), heads(gk, GLA_HEADS),
                      heads(gv, GLA_HEADS), heads(log_a, GLA_HEADS))
    o_a = rmsnorm(o_a.transpose(0, 2, 1, 3), gla_norm)
    o_a = o_a * jax.nn.silu(gog.reshape(B, S, GLA_HEADS, GLA_DV).astype(jnp.float32))
    y_a = o_a.reshape(B, S, GLA_V_W).astype(u.dtype) @ w_br_gla

    o_b = moba_attention(heads(mq, MOBA_HEADS), heads(mk, MOBA_HEADS), heads(mv, MOBA_HEADS), rel_bias)
    y_b = o_b.transpose(0, 2, 1, 3).reshape(B, S, MOBA_W).astype(u.dtype) @ w_br_moba

    merged = jax.nn.sigmoid(ga) * y_a + jax.nn.sigmoid(gb) * y_b
    return merged @ w_out


def setup_inputs(seed: int = 0) -> dict:
    key = jax.random.key(seed)
    ks = jax.random.split(key, 24)
    L, D, F = DEPTH, D_MODEL, D_FF
    nrm = lambda k, shape, fan_in: jax.random.normal(k, shape, jnp.float32) * (fan_in ** -0.5)
    gain = lambda k, shape: 1.0 + 0.05 * jax.random.normal(k, shape, jnp.float32)
    return {
        "x": jax.random.normal(ks[0], (BATCH, SEQ, D), jnp.float32),
        "c": jax.random.normal(ks[1], (BATCH, D), jnp.float32),
        "w_ada": nrm(ks[2], (L, D, N_MOD * D), D) * 0.5,
        "b_ada": 0.01 * jax.random.normal(ks[3], (L, N_MOD * D), jnp.float32),
        "norm_ff1": gain(ks[4], (L, D)),
        "w_ff1_gate": nrm(ks[5], (L, D, F), D),
        "w_ff1_up": nrm(ks[6], (L, D, F), D),
        "w_ff1_down": nrm(ks[7], (L, F, D), F),
        "norm_mix": gain(ks[8], (L, D)),
        "w_in": nrm(ks[9], (L, D, IN_WIDTH), D),
        "w_gla_lr": nrm(ks[10], (L, GLA_LOWRANK, GLA_QK_W), GLA_LOWRANK),
        "b_gla_lr": 0.1 * jax.random.normal(ks[11], (L, GLA_QK_W), jnp.float32),
        "gla_norm": gain(ks[12], (L, GLA_DV)),
        "rel_bias": 0.5 * jax.random.normal(ks[13], (MOBA_HEADS, NUM_BUCKETS), jnp.float32),
        "w_br_gla": nrm(ks[14], (L, GLA_V_W, D), GLA_V_W),
        "w_br_moba": nrm(ks[15], (L, MOBA_W, D), MOBA_W),
        "w_out": nrm(ks[16], (L, D, D), D),
        "norm_ff2": gain(ks[17], (L, D)),
        "w_ff2_gate": nrm(ks[18], (L, D, F), D),
        "w_ff2_up": nrm(ks[19], (L, D, F), D),
        "w_ff2_down": nrm(ks[20], (L, F, D), F),
        "norm_final": gain(ks[21], (D,)),
    }


def reference(x, c, w_ada, b_ada, norm_ff1, w_ff1_gate, w_ff1_up, w_ff1_down, norm_mix, w_in,
              w_gla_lr, b_gla_lr, gla_norm, rel_bias, w_br_gla, w_br_moba, w_out, norm_ff2,
              w_ff2_gate, w_ff2_up, w_ff2_down, norm_final):
    h = x
    c_act = jax.nn.silu(c)
    for l in range(DEPTH):
        mod = c_act @ w_ada[l] + b_ada[l]
        sh1, sc1, g1, sh2, sc2, g2, sh3, sc3, g3 = jnp.split(mod, N_MOD, axis=-1)
        u = modulate(rmsnorm(h, norm_ff1[l]), sh1, sc1)
        h = h + FFN_RES * g1[:, None, :] * swiglu(u, w_ff1_gate[l], w_ff1_up[l], w_ff1_down[l])
        u = modulate(rmsnorm(h, norm_mix[l]), sh2, sc2)
        h = h + g2[:, None, :] * token_mixing(u, w_in[l], w_gla_lr[l], b_gla_lr[l], gla_norm[l], rel_bias,
                                              w_br_gla[l], w_br_moba[l], w_out[l])
        u = modulate(rmsnorm(h, norm_ff2[l]), sh3, sc3)
        h = h + FFN_RES * g3[:, None, :] * swiglu(u, w_ff2_gate[l], w_ff2_up[l], w_ff2_down[l])
    return rmsnorm(h, norm_final)
```

```cpp
#include <hip/hip_runtime.h>
#include <cstdio>
#include <cstdint>
#ifndef PROBEMASK
#define PROBEMASK 0
#endif
#ifndef PROBELI
#define PROBELI 1
#endif
#ifndef ONLYMASK
#define ONLYMASK 0x1ffff
#endif

constexpr int D = 1024, BATCH = 4, SEQ = 8192, MTOK = BATCH * SEQ;
constexpr int GH = 4, GDK = 64, GDV = 128, GLR = 16;
constexpr int MH = 4, MDH = 128, MBLK = 256, MTOPK = 3, NBLK = SEQ / MBLK;
constexpr int FF = 2816, NMOD = 9;
constexpr int INW = 5136;
constexpr int S_GLR = 1024, S_GOG = 1040, S_GA = 3088;
constexpr int O_GQ = 0, O_GK = 256, O_GV = 512, O_GOG = 1024, O_MQ = 1536, O_MK = 2048, O_MV = 2560;
constexpr int O_Z = 3072;
constexpr int PMW = 3328;
constexpr int PMN = 3328;
constexpr int PJN = 5376;
constexpr int GTW = 2048;
constexpr float EPS = 1e-6f;

__constant__ unsigned char BUCKET[128] = {0, 1, 2, 3, 4, 5, 6, 7, 8, 9, 10, 11, 12, 13, 14, 15, 16, 16, 16, 17, 17, 18, 18, 18, 19, 19, 19, 20, 20, 20, 20, 21, 21, 21, 21, 22, 22, 22, 22, 22, 23, 23, 23, 23, 23, 23, 24, 24, 24, 24, 24, 24, 25, 25, 25, 25, 25, 25, 25, 26, 26, 26, 26, 26, 26, 26, 26, 27, 27, 27, 27, 27, 27, 27, 27, 27, 27, 28, 28, 28, 28, 28, 28, 28, 28, 28, 28, 29, 29, 29, 29, 29, 29, 29, 29, 29, 29, 29, 29, 30, 30, 30, 30, 30, 30, 30, 30, 30, 30, 30, 30, 30, 30, 31, 31, 31, 31, 31, 31, 31, 31, 31, 31, 31, 31, 31, 31, 31};

__device__ __forceinline__ float silu_f(float x) { return x * __builtin_amdgcn_rcpf(1.f + __expf(-x)); }
__device__ __forceinline__ float sigmoid_f(float x) { return __builtin_amdgcn_rcpf(1.f + __expf(-x)); }
__device__ __forceinline__ float logsigmoid_f(float x) { return fminf(x, 0.f) - log1pf(__expf(-fabsf(x))); }
__device__ __forceinline__ float bf2f(unsigned short v) { return __uint_as_float((unsigned)v << 16); }
typedef float f32x2_t __attribute__((ext_vector_type(2))); typedef __bf16 bf16x2_t __attribute__((ext_vector_type(2)));
__device__ __forceinline__ unsigned pk2(float lo, float hi) { f32x2_t v = {lo, hi}; bf16x2_t b = __builtin_convertvector(v, bf16x2_t); return __builtin_bit_cast(unsigned, b); }
__device__ __forceinline__ float lo_bf(unsigned w) { return __uint_as_float(w << 16); }
__device__ __forceinline__ float hi_bf(unsigned w) { return __uint_as_float(w & 0xffff0000u); }

namespace pg8 {
#define PG8_LAS __attribute__((address_space(3)))
typedef unsigned short bf16_t;
typedef short bf16x8 __attribute__((ext_vector_type(8)));
typedef float f32x4 __attribute__((ext_vector_type(4)));
typedef unsigned u32x4 __attribute__((ext_vector_type(4)));
constexpr int BM = 256, BK = 64, HALF = 128, HTB = HALF * BK * 2  , STAGE_BYTES = 8 * HTB, NXCD = 8, WGM = 8;

__host__ __device__ __forceinline__ int lds_byte(int r, int c) { const int st = (r >> 4) * 2 + (c >> 5), rr = r & 15, cc = c & 31, ob = rr * 64 + cc * 2; return st * 1024 + (ob ^ (((ob >> 9) & 1) << 5)); }
__host__ __device__ __forceinline__ void stage_rc(int b, int& R, int& C) { const int st = b / 1024, sb = b % 1024, swz = sb ^ (((sb >> 9) & 1) << 5); R = (st >> 1) * 16 + swz / 64; C = (st & 1) * 32 + (swz % 64) / 2; }
__host__ __device__ __forceinline__ int perm32(int rho) { const int n = rho >> 4, i = rho & 15; return 8 * (i >> 2) + 4 * n + (i & 3); }

struct Unit { int pm, pn; };
struct Gemm { const bf16_t* A; const bf16_t* Bt; int M, N, K; const bf16_t* A2 = nullptr; int lda = 0; int ksw = 0; };

struct StaticOrder {
    int nM, nN, nwg, G, c;
    __host__ __device__ void init(int M, int N, int G_, int c_) { nM = M / BM; nN = N / BM; nwg = nM * nN; G = G_; c = c_; }
    __host__ __device__ bool next(int i, Unit& u) const {
        const long L = (long)i * G + c; if (L >= nwg) return false;
        int wgid = (int)L; { const int q = nwg / NXCD, r = nwg % NXCD, xcd = wgid % NXCD, off = wgid / NXCD; wgid = (xcd < r ? xcd * (q + 1) : r * (q + 1) + (xcd - r) * q) + off; }
        const int nig = WGM * nN, gid = wgid / nig, fm = gid * WGM, gsz = (nM - fm) < WGM ? (nM - fm) : WGM;
        u.pm = fm + ((wgid % nig) % gsz); u.pn = (wgid % nig) / gsz; return true;
    }
    __device__ __forceinline__ void a_ready(const Unit&) const {}
    __device__ __forceinline__ void done(const Unit&) const {}
};


struct EpiSwiGLU {
    static constexpr bool PERM = true, AFTER_DRAIN = false, HAS_MID = false;
    bf16_t* O; int ldc; int pad;
    __device__ __forceinline__ void operator()(const f32x4 (&acc)[2][2][4][2], const Unit& u, int wr, int wc, int fr, int fq) const {
        const int row0 = u.pm * BM + wr * 64 + fr, col0 = u.pn * HALF + wc * 32 + 8 * fq;
#pragma unroll
        for (int ai = 0; ai < 2; ++ai)
#pragma unroll
            for (int m = 0; m < 4; ++m) {
                bf16_t* rowp = O + (size_t)(row0 + ai * HALF + m * 16) * ldc + col0;
                const f32x4 g0 = acc[ai][0][m][0], g1 = acc[ai][0][m][1], u0 = acc[ai][1][m][0], u1 = acc[ai][1][m][1];
                u32x4 w;
                w.x = pk2(silu_f(g0[0]) * u0[0], silu_f(g0[1]) * u0[1]); w.y = pk2(silu_f(g0[2]) * u0[2], silu_f(g0[3]) * u0[3]);
                w.z = pk2(silu_f(g1[0]) * u1[0], silu_f(g1[1]) * u1[1]); w.w = pk2(silu_f(g1[2]) * u1[2], silu_f(g1[3]) * u1[3]);
                *(u32x4*)rowp = w;
            }
    }
};
template <bool BASEBF> struct EpiResid {
    static constexpr bool PERM = true, AFTER_DRAIN = false, HAS_MID = false;
    const void* base; bf16_t* out; const float* gate; float fac;
    __device__ __forceinline__ void operator()(const f32x4 (&acc)[2][2][4][2], const Unit& u, int wr, int wc, int fr, int fq) const {
        const int row0 = u.pm * BM + wr * 64 + fr, col0 = u.pn * BM + wc * 32 + 8 * fq;
        const float* gp = gate + (size_t)(u.pm / (SEQ / BM)) * (NMOD * D) + col0;
#pragma unroll
        for (int bj = 0; bj < 2; ++bj) {
            const f32x4 ga = *(const f32x4*)(gp + bj * HALF) * fac, gb = *(const f32x4*)(gp + bj * HALF + 4) * fac;
#pragma unroll
            for (int ai = 0; ai < 2; ++ai)
#pragma unroll
                for (int m = 0; m < 4; ++m) {
                    const size_t off = (size_t)(row0 + ai * HALF + m * 16) * D + col0 + bj * HALF;
                    f32x4 b0, b1;
                    if (BASEBF) { const u32x4 p = *(const u32x4*)((const bf16_t*)base + off); b0 = (f32x4){lo_bf(p.x), hi_bf(p.x), lo_bf(p.y), hi_bf(p.y)}; b1 = (f32x4){lo_bf(p.z), hi_bf(p.z), lo_bf(p.w), hi_bf(p.w)}; }
                    else { b0 = *(const f32x4*)((const float*)base + off); b1 = *(const f32x4*)((const float*)base + off + 4); }
                    const f32x4 v0 = b0 + ga * acc[ai][bj][m][0], v1 = b1 + gb * acc[ai][bj][m][1];
                    u32x4 w; w.x = pk2(v0[0], v0[1]); w.y = pk2(v0[2], v0[3]); w.z = pk2(v1[0], v1[1]); w.w = pk2(v1[2], v1[3]);
                    *(u32x4*)(out + off) = w;
                    if (BASEBF ? (m == 3 && ai == 1) : (m == 3)) asm volatile("" ::: "memory");
                }
        }
    }
};
template <int ACT> struct EpiBf16 {
    static constexpr bool PERM = true, AFTER_DRAIN = false, HAS_MID = false;
    bf16_t* O; int ldc; int ncols; bf16_t* Z; const float* zb;
    __device__ __forceinline__ void operator()(const f32x4 (&acc)[2][2][4][2], const Unit& u, int wr, int wc, int fr, int fq) const {
        const int row0 = u.pm * BM + wr * 64 + fr, col0 = u.pn * BM + wc * 32 + 8 * fq;
        const bool isz = u.pn * BM >= ncols;
        bf16_t* ob = isz ? Z : O; const int ld = isz ? BM : ldc, cb = isz ? col0 - ncols : col0;
        f32x4 bv[2][2];
#pragma unroll
        for (int bj = 0; bj < 2; ++bj) { bv[bj][0] = isz ? *(const f32x4*)(zb + cb + bj * HALF) : (f32x4){0.f, 0.f, 0.f, 0.f}; bv[bj][1] = isz ? *(const f32x4*)(zb + cb + bj * HALF + 4) : (f32x4){0.f, 0.f, 0.f, 0.f}; }
#pragma unroll
        for (int ai = 0; ai < 2; ++ai)
#pragma unroll
            for (int m = 0; m < 4; ++m) {
                bf16_t* rowp = ob + (size_t)(row0 + ai * HALF + m * 16) * ld + cb;
#pragma unroll
                for (int bj = 0; bj < 2; ++bj) {
                    f32x4 v0 = acc[ai][bj][m][0] + bv[bj][0], v1 = acc[ai][bj][m][1] + bv[bj][1];
                    if (ACT == 1) {
#pragma unroll
                        for (int i = 0; i < 4; ++i) { v0[i] = sigmoid_f(v0[i]); v1[i] = sigmoid_f(v1[i]); }
                    }
                    u32x4 w; w.x = pk2(v0[0], v0[1]); w.y = pk2(v0[2], v0[3]); w.z = pk2(v1[0], v1[1]); w.w = pk2(v1[2], v1[3]);
                    *(u32x4*)(rowp + bj * HALF) = w;
                }
            }
    }
};
struct EpiGateMul {
    static constexpr bool PERM = true, AFTER_DRAIN = false, HAS_MID = false;
    bf16_t* O; const bf16_t* gates; int goff; int add;
    __device__ __forceinline__ void operator()(const f32x4 (&acc)[2][2][4][2], const Unit& u, int wr, int wc, int fr, int fq) const {
        const int row0 = u.pm * BM + wr * 64 + fr, col0 = u.pn * BM + wc * 32 + 8 * fq;
#pragma unroll
        for (int ai = 0; ai < 2; ++ai)
#pragma unroll
            for (int m = 0; m < 4; ++m) {
                const int row = row0 + ai * HALF + m * 16;
#pragma unroll
                for (int bj = 0; bj < 2; ++bj) {
                    const int col = col0 + bj * HALF;
                    const u32x4 g = *(const u32x4*)(gates + (size_t)row * GTW + goff + col);
                    bf16_t* op = O + (size_t)row * D + col;
                    const f32x4 a0 = acc[ai][bj][m][0], a1 = acc[ai][bj][m][1];
                    float t[8] = {lo_bf(g.x) * a0[0], hi_bf(g.x) * a0[1], lo_bf(g.y) * a0[2], hi_bf(g.y) * a0[3], lo_bf(g.z) * a1[0], hi_bf(g.z) * a1[1], lo_bf(g.w) * a1[2], hi_bf(g.w) * a1[3]};
                    if (add) { const u32x4 p = *(const u32x4*)op;
                        t[0] += lo_bf(p.x); t[1] += hi_bf(p.x); t[2] += lo_bf(p.y); t[3] += hi_bf(p.y); t[4] += lo_bf(p.z); t[5] += hi_bf(p.z); t[6] += lo_bf(p.w); t[7] += hi_bf(p.w); }
                    u32x4 w; w.x = pk2(t[0], t[1]); w.y = pk2(t[2], t[3]); w.z = pk2(t[4], t[5]); w.w = pk2(t[6], t[7]);
                    *(u32x4*)op = w;
                }
            }
    }
};
typedef unsigned u32x2 __attribute__((ext_vector_type(2)));
struct EpiProj {
    static constexpr bool PERM = true, AFTER_DRAIN = false, HAS_MID = false;
    bf16_t* O; unsigned char* G8; const float* zb;
    __device__ __forceinline__ void operator()(const f32x4 (&acc)[2][2][4][2], const Unit& u, int wr, int wc, int fr, int fq) const {
        const int row0 = u.pm * BM + wr * 64 + fr, col0 = u.pn * BM + wc * 32 + 8 * fq;
        if (u.pn * BM < PMN) {
            const bool isz = u.pn * BM == O_Z;
            f32x4 bv[2][2];
#pragma unroll
            for (int bj = 0; bj < 2; ++bj) { bv[bj][0] = isz ? *(const f32x4*)(zb + col0 - O_Z + bj * HALF) : (f32x4){0.f, 0.f, 0.f, 0.f}; bv[bj][1] = isz ? *(const f32x4*)(zb + col0 - O_Z + bj * HALF + 4) : (f32x4){0.f, 0.f, 0.f, 0.f}; }
#pragma unroll
            for (int ai = 0; ai < 2; ++ai)
#pragma unroll
                for (int m = 0; m < 4; ++m) {
                    bf16_t* rowp = O + (size_t)(row0 + ai * HALF + m * 16) * PMW + col0;
#pragma unroll
                    for (int bj = 0; bj < 2; ++bj) {
                        const f32x4 v0 = acc[ai][bj][m][0] + bv[bj][0], v1 = acc[ai][bj][m][1] + bv[bj][1];
                        u32x4 w; w.x = pk2(v0[0], v0[1]); w.y = pk2(v0[2], v0[3]); w.z = pk2(v1[0], v1[1]); w.w = pk2(v1[2], v1[3]);
                        *(u32x4*)(rowp + bj * HALF) = w;
                    }
                }
        } else {
#pragma unroll
            for (int ai = 0; ai < 2; ++ai)
#pragma unroll
                for (int m = 0; m < 4; ++m) {
                    unsigned char* rowp = G8 + (size_t)(row0 + ai * HALF + m * 16) * GTW + (col0 - PMN);
#pragma unroll
                    for (int bj = 0; bj < 2; ++bj) {
                        unsigned q8[8];
#pragma unroll
                        for (int i = 0; i < 4; ++i) { q8[i] = (unsigned)fmaxf(1.f, __builtin_rintf(sigmoid_f(acc[ai][bj][m][0][i]) * 255.f)); q8[4 + i] = (unsigned)fmaxf(1.f, __builtin_rintf(sigmoid_f(acc[ai][bj][m][1][i]) * 255.f)); }
                        u32x2 w; w.x = q8[0] | (q8[1] << 8) | (q8[2] << 16) | (q8[3] << 24); w.y = q8[4] | (q8[5] << 8) | (q8[6] << 16) | (q8[7] << 24);
                        *(u32x2*)(rowp + bj * HALF) = w;
                    }
                }
        }
    }
};
struct EpiGateCat {
    static constexpr bool PERM = true, AFTER_DRAIN = false, HAS_MID = true;
    bf16_t* O; const unsigned char* gates;
    __device__ __forceinline__ void mid(f32x4 (&acc)[2][2][4][2], const Unit& u, int wr, int wc, int fr, int fq) const {
        const int row0 = u.pm * BM + wr * 64 + fr, col0 = u.pn * BM + wc * 32 + 8 * fq;
#pragma unroll
        for (int ai = 0; ai < 2; ++ai)
#pragma unroll
            for (int m = 0; m < 4; ++m) {
                const unsigned char* gp = gates + (size_t)(row0 + ai * HALF + m * 16) * GTW + col0;
#pragma unroll
                for (int bj = 0; bj < 2; ++bj) {
                    const u32x2 a = *(const u32x2*)(gp + bj * HALF), b = *(const u32x2*)(gp + D + bj * HALF);
#pragma unroll
                    for (int i = 0; i < 4; ++i) {
                        acc[ai][bj][m][0][i] *= (float)((a.x >> (8 * i)) & 0xffu) * __builtin_amdgcn_rcpf((float)((b.x >> (8 * i)) & 0xffu));
                        acc[ai][bj][m][1][i] *= (float)((a.y >> (8 * i)) & 0xffu) * __builtin_amdgcn_rcpf((float)((b.y >> (8 * i)) & 0xffu)); }
                }
                asm volatile("" ::: "memory");
            }
    }
    __device__ __forceinline__ void operator()(const f32x4 (&acc)[2][2][4][2], const Unit& u, int wr, int wc, int fr, int fq) const {
        const int row0 = u.pm * BM + wr * 64 + fr, col0 = u.pn * BM + wc * 32 + 8 * fq;
#pragma unroll
        for (int ai = 0; ai < 2; ++ai)
#pragma unroll
            for (int m = 0; m < 4; ++m) {
                const int row = row0 + ai * HALF + m * 16;
#pragma unroll
                for (int bj = 0; bj < 2; ++bj) {
                    const int col = col0 + bj * HALF;
                    const u32x2 g = *(const u32x2*)(gates + (size_t)row * GTW + D + col);
                    const f32x4 a0 = acc[ai][bj][m][0], a1 = acc[ai][bj][m][1];
                    float t[8];
#pragma unroll
                    for (int i = 0; i < 4; ++i) { t[i] = a0[i] * ((float)((g.x >> (8 * i)) & 0xffu) * (1.f / 255.f)); t[4 + i] = a1[i] * ((float)((g.y >> (8 * i)) & 0xffu) * (1.f / 255.f)); }
                    u32x4 w; w.x = pk2(t[0], t[1]); w.y = pk2(t[2], t[3]); w.z = pk2(t[4], t[5]); w.w = pk2(t[6], t[7]);
                    *(u32x4*)(O + (size_t)row * D + col) = w;
                }
            }
    }
};

template <class Epi, class Sched, bool ALIGN_EPI = false, bool SP2 = false>
__device__ __forceinline__ void gemm_phase(PG8_LAS unsigned char* lds, const Gemm g, const Sched& S, const Epi& E, int tid) {
    const int wid = __builtin_amdgcn_readfirstlane(tid >> 6), lane = tid & 63, wr = wid >> 2, wc = wid & 3, fr = lane & 15, fq = lane >> 4;
    const int K = g.K, nt = K / BK, lda = g.lda ? g.lda : K, ksw = g.A2 ? g.ksw : (1 << 30);
    unsigned voffA[2], voffB[2];
#pragma unroll
    for (int i = 0; i < 2; ++i) { int R, C; stage_rc(tid * 16 + i * 8192, R, C); const int Rb = Epi::PERM ? ((R & ~31) + perm32(R & 31)) : R;
        voffA[i] = (unsigned)(R * lda + C) * 2u; voffB[i] = (unsigned)(Rb * K + C) * 2u; }
    const size_t kstep = (size_t)(BK * 2);
    const size_t hstep = (size_t)HALF * K * 2;
    const size_t tstep = 2 * hstep;
    const size_t hstepA = (size_t)HALF * lda * 2, tstepA = 2 * hstepA;
    const char* A2s = g.A2 ? (const char*)g.A2 - (size_t)ksw * kstep : (const char*)g.A;
#define PG8_AP(t_) (((t_) < ksw ? cA : cA2) + (size_t)(t_) * kstep)
    const unsigned ldsw = (unsigned)wid * 1024u;
    const int aoff = lds_byte(wr * 64 + fr, fq * 8), boff = lds_byte(wc * 32 + fr, fq * 8);
#define PG8_SA(b, h) (((b) * 2 + (h)) * HTB)
#define PG8_SB(b, h) ((4 + (b) * 2 + (h)) * HTB)
#define PG8_STAGE(bufoff, gbase, voff) do { _Pragma("unroll") for (int _i = 0; _i < 2; ++_i) \
        __builtin_amdgcn_global_load_lds((const unsigned*)((const char*)(gbase) + (voff)[_i]), (PG8_LAS unsigned*)(lds + (bufoff) + ldsw + _i * 8192), 16, 0, 0); } while (0)
#define PG8_LDA(dst, b, h) do { _Pragma("unroll") for (int m = 0; m < 4; ++m) _Pragma("unroll") for (int k = 0; k < 2; ++k) dst[m][k] = *(const PG8_LAS bf16x8*)(lds + PG8_SA(b, h) + aoff + m * 2048 + k * 1024); } while (0)
#define PG8_LDB(dst, b, h) do { _Pragma("unroll") for (int n = 0; n < 2; ++n) _Pragma("unroll") for (int k = 0; k < 2; ++k) dst[n][k] = *(const PG8_LAS bf16x8*)(lds + PG8_SB(b, h) + boff + n * 2048 + k * 1024); } while (0)
#define PG8_MMA(ai, bj, At, Bt) do { __builtin_amdgcn_s_setprio(1); _Pragma("unroll") for (int m = 0; m < 4; ++m) _Pragma("unroll") for (int n = 0; n < 2; ++n) _Pragma("unroll") for (int k = 0; k < 2; ++k) \
        acc[ai][bj][m][n] = __builtin_amdgcn_mfma_f32_16x16x32_bf16(Bt[n][k], At[m][k], acc[ai][bj][m][n], 0, 0, 0); __builtin_amdgcn_s_setprio(0); } while (0)
#define PG8_WAIT_V(n) asm volatile("s_waitcnt vmcnt(" #n ")" ::: "memory")
#define PG8_WAIT_L(n) asm volatile("s_waitcnt lgkmcnt(" #n ")" ::: "memory")
#define PG8_BAR __builtin_amdgcn_s_barrier()
#define PG8_SCHED __builtin_amdgcn_sched_barrier(0)
    Unit cur, nxt; int ui = 0;
    if (!S.next(0, cur)) return;
    f32x4 acc[2][2][4][2];
#pragma unroll
    for (int a = 0; a < 2; ++a)
#pragma unroll
        for (int b = 0; b < 2; ++b)
#pragma unroll
            for (int m = 0; m < 4; ++m)
#pragma unroll
                for (int n = 0; n < 2; ++n) acc[a][b][m][n] = (f32x4){0.f, 0.f, 0.f, 0.f};
    bf16x8 At[4][2], B0[2][2], B1[2][2];
    const char* cA = (const char*)g.A + (size_t)cur.pm * tstepA; const char* cB = (const char*)g.Bt + (size_t)cur.pn * tstep; const char* cA2 = A2s + (size_t)cur.pm * tstepA;
    S.a_ready(cur);
    if constexpr (SP2) {
        PG8_STAGE(PG8_SB(0, 0), cB, voffB); PG8_STAGE(PG8_SB(0, 1), cB + hstep, voffB); PG8_STAGE(PG8_SA(0, 0), cA, voffA); PG8_STAGE(PG8_SA(0, 1), cA + hstepA, voffA);
        if (wr == 1) PG8_BAR;
        PG8_WAIT_V(2); PG8_BAR;
        PG8_STAGE(PG8_SB(1, 0), cB + kstep, voffB); PG8_STAGE(PG8_SA(1, 0), cA + kstep, voffA); PG8_STAGE(PG8_SB(1, 1), cB + hstep + kstep, voffB);
        PG8_WAIT_V(6); PG8_BAR;
    } else {
        PG8_STAGE(PG8_SB(0, 0), cB, voffB); PG8_STAGE(PG8_SA(0, 0), cA, voffA); PG8_STAGE(PG8_SB(0, 1), cB + hstep, voffB); PG8_STAGE(PG8_SA(0, 1), cA + hstepA, voffA);
        if (wr == 1) PG8_BAR;
        PG8_WAIT_V(4); PG8_BAR;
        PG8_STAGE(PG8_SB(1, 0), cB + kstep, voffB); PG8_STAGE(PG8_SA(1, 0), cA + kstep, voffA); PG8_STAGE(PG8_SB(1, 1), cB + hstep + kstep, voffB);
        PG8_WAIT_V(6); PG8_BAR;
    }
    for (;;) {
        const bool has_next = S.next(ui + 1, nxt);
        const char* nA = has_next ? (const char*)g.A + (size_t)nxt.pm * tstepA : cA; const char* nB = has_next ? (const char*)g.Bt + (size_t)nxt.pn * tstep : cB;
        const char* nA2 = has_next ? A2s + (size_t)nxt.pm * tstepA : cA2;
        for (int t = 0; t < nt; t += 2) {
            const bool last = (t == nt - 2);
            if constexpr (Epi::HAS_MID) { if (t == ksw) E.mid(acc, cur, wr, wc, fr, fq); }
            const char* a1 = PG8_AP(t + 1);
            const char* a2 = last ? nA : PG8_AP(t + 2); const char* b2 = last ? nB : cB + (size_t)(t + 2) * kstep;
            const char* a3 = a2 + kstep; const char* b3 = b2 + kstep;
            if (last && has_next) S.a_ready(nxt);
            if constexpr (SP2) {
            PG8_LDB(B0, 0, 0); PG8_LDB(B1, 0, 1); PG8_SCHED; PG8_LDA(At, 0, 0); PG8_STAGE(PG8_SA(1, 1), a1 + hstepA, voffA);
            PG8_WAIT_V(8); PG8_WAIT_L(0); PG8_BAR; PG8_MMA(0, 0, At, B0); PG8_MMA(0, 1, At, B1); PG8_BAR; PG8_SCHED;
            PG8_LDA(At, 0, 1); PG8_STAGE(PG8_SB(0, 0), b2, voffB); PG8_STAGE(PG8_SB(0, 1), b2 + hstep, voffB); PG8_STAGE(PG8_SA(0, 0), a2, voffA);
            PG8_WAIT_V(8); PG8_WAIT_L(0); PG8_BAR; PG8_MMA(1, 0, At, B0); PG8_MMA(1, 1, At, B1); PG8_BAR; PG8_SCHED;
            PG8_LDB(B0, 1, 0); PG8_LDB(B1, 1, 1); PG8_SCHED; PG8_LDA(At, 1, 0); PG8_STAGE(PG8_SA(0, 1), a2 + hstepA, voffA);
            PG8_WAIT_V(8); PG8_WAIT_L(0); PG8_BAR; PG8_MMA(0, 0, At, B0); PG8_MMA(0, 1, At, B1); PG8_BAR; PG8_SCHED;
            PG8_LDA(At, 1, 1); PG8_STAGE(PG8_SB(1, 0), b3, voffB); PG8_STAGE(PG8_SB(1, 1), b3 + hstep, voffB); PG8_STAGE(PG8_SA(1, 0), a3, voffA);
            PG8_WAIT_V(8); PG8_WAIT_L(0); PG8_BAR; PG8_MMA(1, 0, At, B0); PG8_MMA(1, 1, At, B1); PG8_BAR; PG8_SCHED;
            } else {
            PG8_LDB(B0, 0, 0); PG8_SCHED; PG8_LDA(At, 0, 0); PG8_STAGE(PG8_SA(1, 1), a1 + hstepA, voffA);
            PG8_WAIT_L(8); PG8_BAR; PG8_WAIT_L(0); PG8_MMA(0, 0, At, B0); PG8_BAR; PG8_SCHED;
            PG8_LDB(B1, 0, 1); PG8_STAGE(PG8_SB(0, 0), b2, voffB);
            PG8_BAR; PG8_WAIT_L(0); PG8_MMA(0, 1, At, B1); PG8_BAR;
            PG8_LDA(At, 0, 1); PG8_STAGE(PG8_SA(0, 0), a2, voffA);
            PG8_BAR; PG8_WAIT_L(0); PG8_MMA(1, 0, At, B0); PG8_BAR; PG8_SCHED;
            PG8_STAGE(PG8_SB(0, 1), b2 + hstep, voffB);
            PG8_WAIT_V(6); PG8_BAR; PG8_MMA(1, 1, At, B1); PG8_BAR;
            PG8_LDB(B0, 1, 0); PG8_SCHED; PG8_LDA(At, 1, 0); PG8_STAGE(PG8_SA(0, 1), a2 + hstepA, voffA);
            PG8_WAIT_L(8); PG8_BAR; PG8_WAIT_L(0); PG8_MMA(0, 0, At, B0); PG8_BAR; PG8_SCHED;
            PG8_LDB(B1, 1, 1); PG8_STAGE(PG8_SB(1, 0), b3, voffB);
            PG8_BAR; PG8_WAIT_L(0); PG8_MMA(0, 1, At, B1); PG8_BAR;
            PG8_LDA(At, 1, 1); PG8_STAGE(PG8_SA(1, 0), a3, voffA);
            PG8_BAR; PG8_WAIT_L(0); PG8_MMA(1, 0, At, B0); PG8_BAR; PG8_SCHED;
            PG8_STAGE(PG8_SB(1, 1), b3 + hstep, voffB);
            PG8_WAIT_V(6); PG8_BAR; PG8_MMA(1, 1, At, B1); PG8_BAR;
            }
        }
        if constexpr (ALIGN_EPI) { if (wr == 0) PG8_BAR; }
        if constexpr (!Epi::AFTER_DRAIN) { E(acc, cur, wr, wc, fr, fq); S.done(cur); }
        if (!has_next) break;
#pragma unroll
        for (int a = 0; a < 2; ++a)
#pragma unroll
            for (int b = 0; b < 2; ++b)
#pragma unroll
                for (int m = 0; m < 4; ++m)
#pragma unroll
                    for (int n = 0; n < 2; ++n) acc[a][b][m][n] = (f32x4){0.f, 0.f, 0.f, 0.f};
        cur = nxt; cA = nA; cB = nB; cA2 = nA2; ++ui;
        if constexpr (ALIGN_EPI) { if (wr == 1) PG8_BAR; }
    }
    PG8_WAIT_V(0);
    if constexpr (!ALIGN_EPI) { if (wr == 0) PG8_BAR; }
    PG8_BAR;
    if constexpr (Epi::AFTER_DRAIN) { E.fused(acc, cur, wr, wc, fr, fq, lds, wid, lane); S.done(cur); }
#undef PG8_SA
#undef PG8_AP
#undef PG8_SB
#undef PG8_STAGE
#undef PG8_LDA
#undef PG8_LDB
#undef PG8_MMA
#undef PG8_WAIT_V
#undef PG8_WAIT_L
#undef PG8_BAR
#undef PG8_SCHED
}
}

constexpr size_t MiB = 1u << 20;
constexpr size_t WS_CTL = 0, CTL_ZERO_BYTES = 1 * MiB;
constexpr size_t WS_MOD = 1 * MiB;
constexpr size_t WS_KMEAN = 1 * MiB + 512 * 1024;
constexpr size_t WS_W = 4 * MiB;
constexpr size_t WS_W1GU = WS_W, WS_W1D = WS_W + 11 * MiB, WS_WIN = WS_W + 17 * MiB, WS_WBRA = WS_W + 28 * MiB, WS_WBRB = WS_W + 29 * MiB, WS_WOUT = WS_W + 30 * MiB,
                 WS_W2GU = WS_W + 32 * MiB, WS_W2D = WS_W + 43 * MiB;
constexpr size_t WS_LIST = 53 * MiB, WS_ML = 57 * MiB;
constexpr size_t WS_U = 60 * MiB;
constexpr size_t WS_BIG = 124 * MiB;
constexpr size_t WS_VTG = WS_U;
constexpr size_t WS_PART = 332 * MiB;
constexpr size_t WS_S = 428 * MiB;
constexpr size_t WS_OA = 460 * MiB;
constexpr size_t WS_END = 512 * MiB;
constexpr int CW_BAR = 4096;
constexpr int CW_MCNT = 65536;

constexpr int RING_OFF = 0;
constexpr int LDS_BYTES = 163840;
constexpr int LDSCTL_OFF = LDS_BYTES - 512, MISC_OFF = LDSCTL_OFF + 320;
constexpr int NWAVES = 8;

#define GAS __attribute__((address_space(1)))
#define LAS __attribute__((address_space(3)))
typedef unsigned short bf16;
typedef unsigned v4u __attribute__((ext_vector_type(4)));
typedef unsigned v2u __attribute__((ext_vector_type(2)));
typedef float f32x4 __attribute__((ext_vector_type(4)));
typedef short bf16x8 __attribute__((ext_vector_type(8)));
typedef GAS unsigned gu32;
#define RLX_AGENT __ATOMIC_RELAXED, __HIP_MEMORY_SCOPE_AGENT
#define LDS_WAIT() asm volatile("s_waitcnt lgkmcnt(0)" ::: "memory")
#define VM_WAIT() asm volatile("s_waitcnt vmcnt(0)" ::: "memory")


struct Args { const float* in[22]; float* out; unsigned char* ws; int ph_mask, li, pad0, pad1; };
enum { I_X = 0, I_C, I_WADA, I_BADA, I_NFF1, I_W1G, I_W1U, I_W1D, I_NMIX, I_WIN, I_WLR, I_BLR, I_GNORM, I_RELB, I_WBRA, I_WBRB, I_WOUT, I_NFF2, I_W2G, I_W2U, I_W2D, I_NFIN };

__device__ __forceinline__ float wave_sum(float v) {
#pragma unroll
    for (int o = 1; o < 64; o <<= 1) v += __shfl_xor(v, o);
    return v;
}

#define XB_TMO      128
#define XB_XCNT(j)  (256  + 64 * (j))
#define XB_XSUB(j)  (1280 + 64 * (j))
#define XB_XGEN(j)  (2304 + 64 * (j))
#define XB_TOP      3328
#define XB_TOPGEN   3392
#define XCD_BAR_WORDS 3456
#define XB_SPIN_CAP (1u << 18)

__device__ __forceinline__ unsigned xb_ld(unsigned* p)              { return __hip_atomic_load(p, __ATOMIC_RELAXED, __HIP_MEMORY_SCOPE_AGENT); }
__device__ __forceinline__ unsigned xb_add(unsigned* p, unsigned v) { return __hip_atomic_fetch_add(p, v, __ATOMIC_RELAXED, __HIP_MEMORY_SCOPE_AGENT); }
__device__ __forceinline__ unsigned xb_xcc_id() { return (unsigned)__builtin_amdgcn_s_getreg((3 << 11) | 20) & 0xFu; }
#define XB_SPIN(cond, bar) do { unsigned _sp = 0; while (cond) { __builtin_amdgcn_s_sleep(1); \
    if ((++_sp & 255u) == 0u) { if (xb_ld(&(bar)[XB_TMO])) break; if (_sp > XB_SPIN_CAP) { atomicAdd(&(bar)[XB_TMO], 1u); break; } } } } while (0)

struct XcdBarrier {
    unsigned* bar; unsigned x;
    volatile LAS unsigned* st;
};

__device__ __forceinline__ XcdBarrier xcd_barrier_post(unsigned* bar, volatile LAS unsigned* st) {
    XcdBarrier b; b.bar = bar; b.x = xb_xcc_id(); b.st = st;
    if (threadIdx.x == 0) (void)xb_add(&bar[XB_XCNT(b.x)], 1u);
    return b;
}
__device__ __forceinline__ void xcd_barrier_complete(unsigned* bar, unsigned x, unsigned& nloc, unsigned& nx) {
    const unsigned G = gridDim.x * gridDim.y * gridDim.z;
    unsigned sum, cnt, mine, sp = 0u;
    for (;;) {
        sum = 0u; cnt = 0u; mine = 0u;
#pragma unroll
        for (unsigned j = 0; j < 16; ++j) { const unsigned c = xb_ld(&bar[XB_XCNT(j)]); sum += c; cnt += (c > 0u) ? 1u : 0u; mine = (j == x) ? c : mine; }
        if (sum == G) break;
        __builtin_amdgcn_s_sleep(1);
        if ((++sp & 255u) == 0u) { if (xb_ld(&bar[XB_TMO])) break; if (sp > XB_SPIN_CAP) { atomicAdd(&bar[XB_TMO], 1u); break; } }
    }
    nloc = mine > 0u ? mine : 1u; nx = cnt > 0u ? cnt : 1u;
}

__device__ __forceinline__ void xcd_barrier(const XcdBarrier& b) {
    asm volatile("s_waitcnt vmcnt(0)" ::: "memory");
    __syncthreads();
    if (threadIdx.x == 0) {
        unsigned* bar = b.bar;
        __builtin_amdgcn_s_waitcnt(0);
        unsigned nloc = b.st[0], nx = b.st[1];
        if (nloc == 0u) { xcd_barrier_complete(bar, b.x, nloc, nx); b.st[0] = nloc; b.st[1] = nx; }
        const unsigned old = xb_add(&bar[XB_XSUB(b.x)], 1u);
        const unsigned gen = old / nloc;
        if (old + 1u == (gen + 1u) * nloc) {
            __builtin_amdgcn_fence(__ATOMIC_RELEASE, "agent");
            asm volatile("s_waitcnt vmcnt(0)" ::: "memory");
            const unsigned og = xb_add(&bar[XB_TOP], 1u);
            const unsigned tg = og / nx;
            if (og + 1u == (tg + 1u) * nx) xb_add(&bar[XB_TOPGEN], 1u);
            else XB_SPIN(xb_ld(&bar[XB_TOPGEN]) == tg, bar);
            __builtin_amdgcn_fence(__ATOMIC_ACQUIRE, "agent");
            xb_add(&bar[XB_XGEN(b.x)], 1u);
            asm volatile("s_waitcnt vmcnt(0)" ::: "memory");
        } else {
            XB_SPIN(xb_ld(&bar[XB_XGEN(b.x)]) == gen, bar);
            __builtin_amdgcn_fence(__ATOMIC_ACQUIRE, "agent");
            asm volatile("s_waitcnt vmcnt(0)" ::: "memory");
        }
    }
    __syncthreads();
}

constexpr size_t WS_DEC = 2 * MiB;
constexpr int GLA_UNITS = BATCH * GH * (SEQ / 64);
constexpr int GL_QT = 0, GL_KK = 9216, GL_VT = 18432, GL_PP = 36864, GL_OF = 46080, GL_WS = 79872, GL_RAW = 81920;
typedef float f32x4_t __attribute__((ext_vector_type(4)));
__device__ __forceinline__ f32x4 mfma16(bf16x8 a, bf16x8 b, f32x4 c) { return __builtin_amdgcn_mfma_f32_16x16x32_bf16(a, b, c, 0, 0, 0); }
__device__ __forceinline__ float logsig_fast(float x) { return fminf(x, 0.f) - __logf(1.f + __expf(-fabsf(x))); }

struct GlaIn {
    v4u zr, qr, kr;
    v4u vv[2];
    v4u gg[2];
    bf16x8 sf[2];
};
template <bool OUT>
__device__ __forceinline__ void gla_load(const Args& a, int unit, int tid, int lane, int wave, GlaIn& in) {
    const int bh = unit >> 7, c = unit & 127, b = bh >> 2, h = bh & 3;
    const bf16* P0 = (const bf16*)(a.ws + WS_BIG) + (size_t)(b * SEQ + c * 64) * PMW;
    { const bf16* zb = P0 + O_Z + h * GDK;
      const int t = 8 * wave + (lane >> 3), d8 = 8 * (lane & 7);
      in.zr = *(const v4u*)(zb + (size_t)t * PMW + d8);
      in.kr = *(const v4u*)(P0 + (size_t)t * PMW + O_GK + h * GDK + d8);
      in.qr = OUT ? *(const v4u*)(P0 + (size_t)t * PMW + O_GQ + h * GDK + d8) : (v4u){0u, 0u, 0u, 0u}; }
#pragma unroll
    for (int rep = 0; rep < 2; ++rep) in.vv[rep] = *(const v4u*)(P0 + (size_t)(2 * (tid & 31) + rep) * PMW + O_GV + h * GDV + (tid >> 5) * 8);
    if (OUT) {
        const int t = tid >> 3, g = tid & 7;
#pragma unroll
        for (int hh = 0; hh < 2; ++hh) in.gg[hh] = *(const v4u*)(P0 + (size_t)t * PMW + O_GOG + h * GDV + 64 * hh + 8 * g);
        const bf16* ST = (const bf16*)(a.ws + WS_S) + ((size_t)unit * GDV + 16 * wave + (lane & 15)) * GDK + 8 * (lane >> 4);
        in.sf[0] = *(const bf16x8*)ST; in.sf[1] = *(const bf16x8*)(ST + 32);
    }
}
template <bool OUT>
__device__ __forceinline__ void gla_unpack(const GlaIn& in, LAS unsigned char* lds, int wave, int lane, unsigned (&z)[8], unsigned (&qk)[8]) {
    LAS unsigned char* slab = lds + GL_RAW + wave * 3072;
    const int wo = (lane >> 3) * 128 + (lane & 7) * 16;
    *(LAS v4u*)(slab + wo) = in.zr; *(LAS v4u*)(slab + 1024 + wo) = in.kr; if (OUT) *(LAS v4u*)(slab + 2048 + wo) = in.qr;
    const LAS bf16* s16 = (const LAS bf16*)slab + lane;
#pragma unroll
    for (int i = 0; i < 8; ++i) { z[i] = s16[i * 64]; qk[i] = (OUT ? (unsigned)s16[1024 + i * 64] : 0u) << 0; qk[i] = (OUT ? (unsigned)s16[1024 + i * 64] : 0u) | ((unsigned)s16[512 + i * 64] << 16); }
    asm volatile("s_waitcnt lgkmcnt(0)" ::: "memory");
}
__device__ __forceinline__ void gla_gates(const unsigned (&z)[8], int wave, int lane, LAS float* wsum, float (&bc)[8], float& blast) {
    float run = 0.f;
#pragma unroll
    for (int i = 0; i < 8; ++i) {
        run += logsig_fast(lo_bf(z[i])) * (1.f / 16.f);
        bc[i] = run;
    }
    wsum[wave * 64 + lane] = run;
    __syncthreads();
    float off = 0.f, tot = 0.f;
#pragma unroll
    for (int w = 0; w < NWAVES; ++w) { const float v = wsum[w * 64 + lane]; tot += v; off += (w < wave) ? v : 0.f; }
#pragma unroll
    for (int i = 0; i < 8; ++i) bc[i] += off;
    blast = tot;
}
__device__ __forceinline__ void gla_stage_vt(const GlaIn& in, LAS bf16* VT, int tid) {
    LAS unsigned* dst = (LAS unsigned*)VT + ((tid >> 5) * 8) * 36 + (tid & 31);
    const v4u a = in.vv[0], b = in.vv[1];
    dst[0 * 36] = (a.x & 0xffffu) | (b.x << 16); dst[1 * 36] = (a.x >> 16) | (b.x & 0xffff0000u);
    dst[2 * 36] = (a.y & 0xffffu) | (b.y << 16); dst[3 * 36] = (a.y >> 16) | (b.y & 0xffff0000u);
    dst[4 * 36] = (a.z & 0xffffu) | (b.z << 16); dst[5 * 36] = (a.z >> 16) | (b.z & 0xffff0000u);
    dst[6 * 36] = (a.w & 0xffffu) | (b.w << 16); dst[7 * 36] = (a.w >> 16) | (b.w & 0xffff0000u);
}

__device__ __forceinline__ void gla_local_unit(const Args& a, LAS unsigned char* lds, int unit, const GlaIn& in, int tid, int lane, int wave) {
    LAS bf16* KT = (LAS bf16*)(lds + GL_QT); LAS bf16* VT = (LAS bf16*)(lds + GL_VT); LAS float* wsum = (LAS float*)(lds + GL_WS);
    unsigned z[8], qk[8]; gla_unpack<false>(in, lds, wave, lane, z, qk);
    float bc[8], blast;
    gla_gates(z, wave, lane, wsum, bc, blast);
    float kt[8];
#pragma unroll
    for (int i = 0; i < 8; ++i) kt[i] = hi_bf(qk[i]) * __expf(blast - bc[i]);
    { v4u w; w.x = pk2(kt[0], kt[1]); w.y = pk2(kt[2], kt[3]); w.z = pk2(kt[4], kt[5]); w.w = pk2(kt[6], kt[7]); *(LAS v4u*)(KT + lane * 72 + 8 * wave) = w; }
    gla_stage_vt(in, VT, tid);
    if (wave == 0) ((float*)(a.ws + WS_DEC))[(size_t)unit * 64 + lane] = __expf(blast);
    __syncthreads();
    f32x4 acc[4];
#pragma unroll
    for (int dt = 0; dt < 4; ++dt) acc[dt] = (f32x4){0.f, 0.f, 0.f, 0.f};
#pragma unroll
    for (int ks = 0; ks < 2; ++ks) {
        const bf16x8 bfr = *(const LAS bf16x8*)(VT + (16 * wave + (lane & 15)) * 72 + 32 * ks + 8 * (lane >> 4));
#pragma unroll
        for (int dt = 0; dt < 4; ++dt) { const bf16x8 afr = *(const LAS bf16x8*)(KT + (16 * dt + (lane & 15)) * 72 + 32 * ks + 8 * (lane >> 4)); acc[dt] = mfma16(afr, bfr, acc[dt]); }
    }
    bf16* ST = (bf16*)(a.ws + WS_S) + ((size_t)unit * GDV + 16 * wave + (lane & 15)) * GDK + 4 * (lane >> 4);
#pragma unroll
    for (int dt = 0; dt < 4; ++dt) { v2u o; o.x = pk2(acc[dt][0], acc[dt][1]); o.y = pk2(acc[dt][2], acc[dt][3]); *(v2u*)(ST + 16 * dt) = o; }
    __syncthreads();
}
__device__ __forceinline__ void gla_local_phase(const Args& a, LAS unsigned char* lds, int tid, int lane, int wave, int vcu, int G) {
    if (vcu >= GLA_UNITS) return;
    GlaIn A, B; gla_load<false>(a, vcu, tid, lane, wave, A);
    for (int u = vcu;;) {
        if (u + G < GLA_UNITS) gla_load<false>(a, u + G, tid, lane, wave, B);
        gla_local_unit(a, lds, u, A, tid, lane, wave);
        u += G; if (u >= GLA_UNITS) break;
        if (u + G < GLA_UNITS) gla_load<false>(a, u + G, tid, lane, wave, A);
        gla_local_unit(a, lds, u, B, tid, lane, wave);
        u += G; if (u >= GLA_UNITS) break;
    }
}

__device__ __forceinline__ void gla_scan(const Args& a, int gthread) {
    const int dp = gthread & 31, e = (gthread >> 5) & 127, bh = gthread >> 12;
    unsigned* st = (unsigned*)(a.ws + WS_S) + ((size_t)(bh * 128) * GDV + e) * (GDK / 2) + dp;
    const f32x2_t* dec = (const f32x2_t*)(a.ws + WS_DEC) + (size_t)(bh * 128) * (GDK / 2) + dp;
    float s0 = 0.f, s1 = 0.f;
#pragma unroll 32
    for (int c = 0; c < 128; ++c) {
        const unsigned L = st[(size_t)c * (GDV * GDK / 2)]; const f32x2_t d2 = dec[(size_t)c * (GDK / 2)];
        st[(size_t)c * (GDV * GDK / 2)] = pk2(s0, s1);
        s0 = d2.x * s0 + lo_bf(L); s1 = d2.y * s1 + hi_bf(L);
    }
}

__device__ __forceinline__ void gla_out_unit(const Args& a, LAS unsigned char* lds, int unit, const GlaIn& in, const f32x4 (&gnv)[4], int tid, int lane, int wave) {
    const int bh = unit >> 7, c = unit & 127, b = bh >> 2, h = bh & 3;
    const size_t row0 = (size_t)(b * SEQ + c * 64);
    LAS bf16* QT = (LAS bf16*)(lds + GL_QT); LAS bf16* KK = (LAS bf16*)(lds + GL_KK); LAS bf16* VT = (LAS bf16*)(lds + GL_VT); LAS bf16* PP = (LAS bf16*)(lds + GL_PP);
    LAS float* OF = (LAS float*)(lds + GL_OF); LAS float* wsum = (LAS float*)(lds + GL_WS);
    unsigned z[8], qk[8]; gla_unpack<true>(in, lds, wave, lane, z, qk);
    float bc[8], blast;
    gla_gates(z, wave, lane, wsum, bc, blast);
#pragma unroll
    for (int i = 0; i < 8; ++i) {
        const int t = 8 * wave + i;
        const float q = lo_bf(qk[i]) * 0.125f * __expf(bc[i]);
        const float k = hi_bf(qk[i]) * __expf(-bc[i]);
        QT[t * 72 + lane] = (bf16)(pk2(q, 0.f) & 0xffff); KK[t * 72 + lane] = (bf16)(pk2(k, 0.f) & 0xffff);
    }
    gla_stage_vt(in, VT, tid);
    __syncthreads();
    const int fr = lane & 15, fq = lane >> 4;
    {
        const int tt = wave >> 1;
        f32x4 p[2] = {(f32x4){0.f, 0.f, 0.f, 0.f}, (f32x4){0.f, 0.f, 0.f, 0.f}};
#pragma unroll
        for (int ks = 0; ks < 2; ++ks) {
            const bf16x8 afr = *(const LAS bf16x8*)(QT + (16 * tt + fr) * 72 + 32 * ks + 8 * fq);
#pragma unroll
            for (int jj = 0; jj < 2; ++jj) { const int jt = 2 * (wave & 1) + jj; const bf16x8 bfr = *(const LAS bf16x8*)(KK + (16 * jt + fr) * 72 + 32 * ks + 8 * fq); p[jj] = mfma16(afr, bfr, p[jj]); }
        }
#pragma unroll
        for (int jj = 0; jj < 2; ++jj) { const int j = 16 * (2 * (wave & 1) + jj) + fr;
#pragma unroll
            for (int r = 0; r < 4; ++r) { const int t = 16 * tt + 4 * fq + r; PP[t * 72 + j] = (bf16)(pk2(j <= t ? p[jj][r] : 0.f, 0.f) & 0xffff); } }
    }
    f32x4 o[4];
#pragma unroll
    for (int tt = 0; tt < 4; ++tt) o[tt] = (f32x4){0.f, 0.f, 0.f, 0.f};
#pragma unroll
    for (int ks = 0; ks < 2; ++ks) {
#pragma unroll
        for (int tt = 0; tt < 4; ++tt) { const bf16x8 afr = *(const LAS bf16x8*)(QT + (16 * tt + fr) * 72 + 32 * ks + 8 * fq); o[tt] = mfma16(afr, in.sf[ks], o[tt]); }
    }
    __syncthreads();
#pragma unroll
    for (int ks = 0; ks < 2; ++ks) {
        const bf16x8 bfr = *(const LAS bf16x8*)(VT + (16 * wave + fr) * 72 + 32 * ks + 8 * fq);
#pragma unroll
        for (int tt = 0; tt < 4; ++tt) { const bf16x8 afr = *(const LAS bf16x8*)(PP + (16 * tt + fr) * 72 + 32 * ks + 8 * fq); o[tt] = mfma16(afr, bfr, o[tt]); }
    }
#pragma unroll
    for (int tt = 0; tt < 4; ++tt)
#pragma unroll
        for (int r = 0; r < 4; ++r) OF[(16 * tt + 4 * fq + r) * 132 + 16 * wave + fr] = o[tt][r];
    __syncthreads();
    {
        const int t = tid >> 3, g = tid & 7;
        f32x4 v[4]; float s = 0.f;
#pragma unroll
        for (int i = 0; i < 4; ++i) { v[i] = *(const LAS f32x4*)(OF + t * 132 + 64 * (i >> 1) + 8 * g + 4 * (i & 1)); s += (v[i].x * v[i].x + v[i].y * v[i].y) + (v[i].z * v[i].z + v[i].w * v[i].w); }
        s += __shfl_xor(s, 1); s += __shfl_xor(s, 2); s += __shfl_xor(s, 4);
        const float rstd = rsqrtf(s * (1.f / GDV) + EPS);
        bf16* op = (bf16*)(a.ws + WS_OA) + (row0 + t) * (GH * GDV) + h * GDV;
#pragma unroll
        for (int hh = 0; hh < 2; ++hh) {
            const int e0 = 64 * hh + 8 * g;
            const v4u gg = in.gg[hh];
            const f32x4 x0 = v[2 * hh] * rstd * gnv[2 * hh], x1 = v[2 * hh + 1] * rstd * gnv[2 * hh + 1];
            v4u w; w.x = pk2(x0.x * silu_f(lo_bf(gg.x)), x0.y * silu_f(hi_bf(gg.x))); w.y = pk2(x0.z * silu_f(lo_bf(gg.y)), x0.w * silu_f(hi_bf(gg.y)));
            w.z = pk2(x1.x * silu_f(lo_bf(gg.z)), x1.y * silu_f(hi_bf(gg.z))); w.w = pk2(x1.z * silu_f(lo_bf(gg.w)), x1.w * silu_f(hi_bf(gg.w)));
            *(v4u*)(op + e0) = w;
        }
    }
    __syncthreads();
}
__device__ __forceinline__ void gla_out_phase(const Args& a, LAS unsigned char* lds, int tid, int lane, int wave, int vcu, int G) {
    if (vcu >= GLA_UNITS) return;
    f32x4 gnv[4];
    { const int g = tid & 7;
#pragma unroll
      for (int hh = 0; hh < 2; ++hh) { gnv[2 * hh] = *(const f32x4*)(a.in[I_GNORM] + 64 * hh + 8 * g); gnv[2 * hh + 1] = *(const f32x4*)(a.in[I_GNORM] + 64 * hh + 8 * g + 4); } }
    GlaIn A, B; gla_load<true>(a, vcu, tid, lane, wave, A);
    for (int u = vcu;;) {
        if (u + G < GLA_UNITS) gla_load<true>(a, u + G, tid, lane, wave, B);
        gla_out_unit(a, lds, u, A, gnv, tid, lane, wave);
        u += G; if (u >= GLA_UNITS) break;
        if (u + G < GLA_UNITS) gla_load<true>(a, u + G, tid, lane, wave, A);
        gla_out_unit(a, lds, u, B, gnv, tid, lane, wave);
        u += G; if (u >= GLA_UNITS) break;
    }
}

typedef float f32x16 __attribute__((ext_vector_type(16)));
__device__ __forceinline__ f32x16 mfma32(bf16x8 a, bf16x8 b, f32x16 c) { return __builtin_amdgcn_mfma_f32_32x32x16_bf16(a, b, c, 0, 0, 0); }
constexpr float LOG2E = 1.4426950408889634f;
constexpr float QK_C1 = 0.08838834764831845f * 1.4426950408889634f;
constexpr int AT_KS = 0, AT_VT = 65536, AT_TAB = 131072, AT_CNT = 132096, AT_PRE = 134144;
constexpr int LIST_PER_BH = 256 * 496;
__host__ __device__ __forceinline__ int list_off(int n) { return 256 * (31 * n - (n * (n - 1)) / 2); }

__device__ __forceinline__ void moba_prep_unit(const Args& a, LAS unsigned char* lds, int u, int tid) {
    const int bh = u >> 5, n = u & 31, b = bh >> 2, h = bh & 3;
    const bf16* base = (const bf16*)(a.ws + WS_BIG) + (size_t)(b * SEQ + n * MBLK) * PMW + O_MK + h * MDH;
    const int jg = tid >> 4, d0 = (tid & 15) * 8;
    float acc[8];
#pragma unroll
    for (int i = 0; i < 8; ++i) acc[i] = 0.f;
#pragma unroll
    for (int i = 0; i < 8; ++i) { const v4u v = *(const v4u*)(base + (size_t)(jg + 32 * i) * PMW + d0);
        acc[0] += lo_bf(v.x); acc[1] += hi_bf(v.x); acc[2] += lo_bf(v.y); acc[3] += hi_bf(v.y); acc[4] += lo_bf(v.z); acc[5] += hi_bf(v.z); acc[6] += lo_bf(v.w); acc[7] += hi_bf(v.w); }
    LAS float* red = (LAS float*)lds;
    *(LAS f32x4*)(red + jg * 128 + d0) = (f32x4){acc[0], acc[1], acc[2], acc[3]}; *(LAS f32x4*)(red + jg * 128 + d0 + 4) = (f32x4){acc[4], acc[5], acc[6], acc[7]};
    __syncthreads();
    if (tid < 128) { float s = 0.f;
#pragma unroll 8
        for (int j = 0; j < 32; ++j) s += red[j * 128 + tid];
        ((float*)(a.ws + WS_KMEAN))[(size_t)u * MDH + tid] = s * (1.f / MBLK); }
    __syncthreads();
    {
        const bf16* vb = (const bf16*)(a.ws + WS_BIG) + (size_t)(b * SEQ + n * MBLK) * PMW + O_MV + h * MDH;
        LAS unsigned* T = (LAS unsigned*)lds;
#pragma unroll
        for (int i = 0; i < 4; ++i) {
            const int p = (tid & 31) + 32 * i, chn = tid >> 5;
            const v4u x = *(const v4u*)(vb + (size_t)(2 * p) * PMW + 8 * chn), y = *(const v4u*)(vb + (size_t)(2 * p + 1) * PMW + 8 * chn);
            LAS unsigned* dst = T + (8 * chn) * 132 + p;
            dst[0 * 132] = (x.x & 0xffffu) | (y.x << 16); dst[1 * 132] = (x.x >> 16) | (y.x & 0xffff0000u);
            dst[2 * 132] = (x.y & 0xffffu) | (y.y << 16); dst[3 * 132] = (x.y >> 16) | (y.y & 0xffff0000u);
            dst[4 * 132] = (x.z & 0xffffu) | (y.z << 16); dst[5 * 132] = (x.z >> 16) | (y.z & 0xffff0000u);
            dst[6 * 132] = (x.w & 0xffffu) | (y.w << 16); dst[7 * 132] = (x.w >> 16) | (y.w & 0xffff0000u);
        }
        __syncthreads();
        bf16* vt = (bf16*)(a.ws + WS_VTG) + (size_t)u * (MDH * MBLK);
#pragma unroll
        for (int i = 0; i < 8; ++i) { const int idx = tid + 512 * i, d = idx >> 5, oc = idx & 31, j = oc >> 1, hf = oc & 1;
            const v2u lo = *(const LAS v2u*)(T + d * 132 + 8 * j + 2 * hf), hi2 = *(const LAS v2u*)(T + d * 132 + 8 * j + 4 + 2 * hf);
            *(v4u*)(vt + (size_t)d * MBLK + 8 * oc) = (v4u){lo.x, lo.y, hi2.x, hi2.y}; }
        __syncthreads();
    }
}

__device__ __forceinline__ bool topk_better(float va, int ia, float vb, int ib) { return va > vb || (va == vb && ia < ib); }
#define TOPK_INSERT(g_, n_) do { const float tg_ = (g_); const int tn_ = (n_); \
    if (topk_better(tg_, tn_, v0, i0)) { v2 = v1; i2 = i1; v1 = v0; i1 = i0; v0 = tg_; i0 = tn_; } \
    else if (topk_better(tg_, tn_, v1, i1)) { v2 = v1; i2 = i1; v1 = tg_; i1 = tn_; } \
    else if (topk_better(tg_, tn_, v2, i2)) { v2 = tg_; i2 = tn_; } } while (0)
__device__ __forceinline__ void moba_topk_unit(const Args& a, LAS unsigned char* lds, int u, int tid) {
    const int bh = u / 31, cur = 1 + u % 31, b = bh >> 2, h = bh & 3;
    const int lane = tid & 63, wave = tid >> 6, q = lane & 31, hi = lane >> 5;
    LAS float* KM = (LAS float*)lds;
    LAS unsigned* hist = (LAS unsigned*)(lds + 17408);
    const float* kmg = (const float*)(a.ws + WS_KMEAN) + (size_t)(bh * NBLK) * MDH;
    for (int i = tid; i < 32 * MDH; i += NWAVES * 64) { const int n = i >> 7; KM[n * 132 + (i & 127)] = n < cur ? kmg[i] : 0.f; }
    if (tid < 64) hist[tid] = 0u;
    float qv[64];
    { const bf16* qp = (const bf16*)(a.ws + WS_BIG) + (size_t)(b * SEQ + cur * MBLK + 32 * wave + q) * PMW + O_MQ + h * MDH + 64 * hi;
#pragma unroll
      for (int i = 0; i < 8; ++i) { const v4u v = *(const v4u*)(qp + 8 * i);
          qv[8 * i + 0] = lo_bf(v.x); qv[8 * i + 1] = hi_bf(v.x); qv[8 * i + 2] = lo_bf(v.y); qv[8 * i + 3] = hi_bf(v.y); qv[8 * i + 4] = lo_bf(v.z); qv[8 * i + 5] = hi_bf(v.z); qv[8 * i + 6] = lo_bf(v.w); qv[8 * i + 7] = hi_bf(v.w); } }
    __syncthreads();
    f32x16 g;
#pragma unroll
    for (int r = 0; r < 16; ++r) g[r] = 0.f;
    { const LAS f32x4* km = (const LAS f32x4*)(KM + q * 132 + 64 * hi);
#pragma unroll
      for (int s4 = 0; s4 < 16; ++s4) { const f32x4 k4 = km[s4];
          g = __builtin_amdgcn_mfma_f32_32x32x2f32(k4.x, qv[4 * s4 + 0], g, 0, 0, 0); g = __builtin_amdgcn_mfma_f32_32x32x2f32(k4.y, qv[4 * s4 + 1], g, 0, 0, 0);
          g = __builtin_amdgcn_mfma_f32_32x32x2f32(k4.z, qv[4 * s4 + 2], g, 0, 0, 0); g = __builtin_amdgcn_mfma_f32_32x32x2f32(k4.w, qv[4 * s4 + 3], g, 0, 0, 0); } }
    float v0 = -INFINITY, v1 = -INFINITY, v2 = -INFINITY; int i0 = 64, i1 = 64, i2 = 64;
#pragma unroll
    for (int r = 0; r < 16; ++r) { const int n = (r & 3) + 8 * (r >> 2) + 4 * hi; const float gv = n < cur ? g[r] : -INFINITY; if (n < cur) TOPK_INSERT(gv, n); }
    { const float w0 = __shfl_xor(v0, 32), w1 = __shfl_xor(v1, 32), w2 = __shfl_xor(v2, 32); const int j0 = __shfl_xor(i0, 32), j1 = __shfl_xor(i1, 32), j2 = __shfl_xor(i2, 32);
      if (j0 < 64) TOPK_INSERT(w0, j0);
      if (j1 < 64) TOPK_INSERT(w1, j1);
      if (j2 < 64) TOPK_INSERT(w2, j2); }
    unsigned p0 = 0, p1 = 0, p2 = 0;
    const int nsel = cur < MTOPK ? cur : MTOPK;
    if (hi == 0) {
        p0 = __hip_atomic_fetch_add(&hist[i0], 1u, __ATOMIC_RELAXED, __HIP_MEMORY_SCOPE_WORKGROUP);
        if (nsel > 1) p1 = __hip_atomic_fetch_add(&hist[i1], 1u, __ATOMIC_RELAXED, __HIP_MEMORY_SCOPE_WORKGROUP);
        if (nsel > 2) p2 = __hip_atomic_fetch_add(&hist[i2], 1u, __ATOMIC_RELAXED, __HIP_MEMORY_SCOPE_WORKGROUP);
    }
    __syncthreads();
    if (tid < cur) hist[32 + tid] = atomicAdd((unsigned*)(a.ws + WS_CTL) + CW_MCNT + bh * NBLK + tid, hist[tid]);
    __syncthreads();
    if (hi == 0) {
        unsigned short* list = (unsigned short*)(a.ws + WS_LIST) + (size_t)bh * LIST_PER_BH;
        const unsigned qs = (unsigned)(cur * MBLK + 32 * wave + q);
        list[list_off(i0) + hist[32 + i0] + p0] = (unsigned short)(qs | (0u << 13));
        if (nsel > 1) list[list_off(i1) + hist[32 + i1] + p1] = (unsigned short)(qs | (1u << 13));
        if (nsel > 2) list[list_off(i2) + hist[32 + i2] + p2] = (unsigned short)(qs | (2u << 13));
    }
    __syncthreads();
}

__device__ __forceinline__ void moba_stage_kv(const Args& a, LAS unsigned char* lds, int b, int h, int n, int tid) {
    const bf16* kg = (const bf16*)(a.ws + WS_BIG) + (size_t)(b * SEQ + n * MBLK) * PMW + O_MK + h * MDH;
    const bf16* vg = (const bf16*)(a.ws + WS_VTG) + (size_t)((b * MH + h) * NBLK + n) * (MDH * MBLK);
    LAS float* TAB = (LAS float*)(lds + AT_TAB);
    if (tid < 129) TAB[tid] = a.in[I_RELB][h * 32 + (tid < 128 ? (int)BUCKET[tid] : 31)] * LOG2E;
    const int wv = __builtin_amdgcn_readfirstlane(tid >> 6), ln = tid & 63;
#pragma unroll
    for (int j = 0; j < 8; ++j) {
        const int g = 8 * j + wv;
        { const int r = 4 * g + (ln >> 4), c = (ln & 15) ^ (r & 15);
          __builtin_amdgcn_global_load_lds((const unsigned*)(kg + (size_t)r * PMW + 8 * c), (LAS unsigned*)(lds + AT_KS + g * 1024), 16, 0, 0); }
        { const int d = 2 * g + (ln >> 5), c = (ln & 31) ^ (d & 15);
          __builtin_amdgcn_global_load_lds((const unsigned*)(vg + (size_t)d * MBLK + 8 * c), (LAS unsigned*)(lds + AT_VT + g * 1024), 16, 0, 0); }
    }
    asm volatile("s_waitcnt vmcnt(0)" ::: "memory");
}
__device__ __forceinline__ void moba_load_q(const Args& a, int b, int h, unsigned e, int hi, bf16x8 (&qf)[8]) {
    const bf16* qp = (const bf16*)(a.ws + WS_BIG) + ((size_t)b * SEQ + (e & 8191u)) * PMW + O_MQ + h * MDH + 8 * hi;
#pragma unroll
    for (int s = 0; s < 8; ++s) qf[s] = *(const bf16x8*)(qp + 16 * s);
}
template <bool OWN>
__device__ __forceinline__ void moba_wave_tile(const Args& a, LAS unsigned char* lds, int b, int h, int n, unsigned e, bf16x8 (&qf)[8], unsigned e_next, bool has_next, int lane, int wave) {
    const int q = lane & 31, hi = lane >> 5;
    const bool valid = (e >> 31) == 0u; const int qpos = (int)(e & 8191u), slot = (int)((e >> 13) & 3u);
    const bool act = OWN ? true : (__any(valid) != 0);
    const int nst = OWN ? (wave + 1) : 8;
    const LAS float* TAB = (const LAS float*)(lds + AT_TAB);
    const int sw = hi ^ (q & 15);
    float m = -INFINITY, l = 0.f;
    f32x16 o[4];
#pragma unroll
    for (int dt = 0; dt < 4; ++dt)
#pragma unroll
        for (int r = 0; r < 16; ++r) o[dt][r] = 0.f;
    if constexpr (OWN) {
    const LAS unsigned char* kq = lds + AT_KS + q * 256;
    const LAS unsigned char* vq = lds + AT_VT + q * 512;
    int kx[8];
#pragma unroll
    for (int ds = 0; ds < 8; ++ds) kx[ds] = ((2 * ds) ^ sw) << 4;
#define QKT(S, i_) do { const LAS unsigned char* kp_ = kq + (i_) * (32 * 256); \
        _Pragma("unroll") for (int r = 0; r < 16; ++r) S[r] = 0.f; \
        _Pragma("unroll") for (int ds = 0; ds < 8; ++ds) { const bf16x8 kf_ = *(const LAS bf16x8*)(kp_ + kx[ds]); S = mfma32(kf_, qf[ds], S); } } while (0)
#define SOFT(S, i_) do { const int d0_ = qpos - (n * MBLK + 32 * (i_) + 4 * hi);        \
        const bool far_ = !OWN && (__all(d0_ - 27 >= 128) != 0); \
        float alpha_, ps_ = 0.f; \
        if (far_) { const float c_ = TAB[128]; \
            float mr_ = fmaxf(fmaxf(S[0], S[1]), S[2]); \
            _Pragma("unroll") for (int r = 3; r < 16; ++r) mr_ = fmaxf(mr_, S[r]); \
            mr_ = fmaxf(mr_, __shfl_xor(mr_, 32)); \
            const float mn_ = fmaxf(m, mr_ * QK_C1 + c_); alpha_ = __builtin_amdgcn_exp2f(m - mn_); m = mn_; \
            const float cm_ = c_ - mn_; \
            _Pragma("unroll") for (int r = 0; r < 16; ++r) { const float p_ = __builtin_amdgcn_exp2f(__builtin_fmaf(S[r], QK_C1, cm_)); S[r] = p_; ps_ += p_; } \
        } else { \
            _Pragma("unroll") for (int r = 0; r < 16; ++r) { const int dist_ = d0_ - ((r & 3) + 8 * (r >> 2)); \
                const int di_ = dist_ < 0 ? 0 : (dist_ > 128 ? 128 : dist_); \
                const float v_ = S[r] * QK_C1 + TAB[di_]; \
                S[r] = (OWN && dist_ < 0) ? -INFINITY : v_; } \
            float mt_ = S[0]; \
            _Pragma("unroll") for (int r = 1; r < 16; ++r) mt_ = fmaxf(mt_, S[r]); \
            mt_ = fmaxf(mt_, __shfl_xor(mt_, 32)); \
            const float mn_ = fmaxf(m, mt_); alpha_ = __builtin_amdgcn_exp2f(m - mn_); m = mn_; \
            _Pragma("unroll") for (int r = 0; r < 16; ++r) { const float p_ = __builtin_amdgcn_exp2f(S[r] - mn_); S[r] = p_; ps_ += p_; } \
        } \
        l = l * alpha_ + ps_; \
        if (__any(alpha_ != 1.f)) { _Pragma("unroll") for (int dt = 0; dt < 4; ++dt) _Pragma("unroll") for (int r = 0; r < 16; ++r) o[dt][r] *= alpha_; } } while (0)
#define PVT(S, i_) do { _Pragma("unroll") for (int ss = 0; ss < 2; ++ss) { \
            v4u pw_; pw_.x = pk2(S[8 * ss + 0], S[8 * ss + 1]); pw_.y = pk2(S[8 * ss + 2], S[8 * ss + 3]); pw_.z = pk2(S[8 * ss + 4], S[8 * ss + 5]); pw_.w = pk2(S[8 * ss + 6], S[8 * ss + 7]); \
            const bf16x8 pf_ = __builtin_bit_cast(bf16x8, pw_); \
            const int vo_ = ((2 * (2 * (i_) + ss)) ^ sw) << 4;                   \
            _Pragma("unroll") for (int dt = 0; dt < 4; ++dt) { const bf16x8 vf_ = *(const LAS bf16x8*)(vq + dt * (32 * 512) + vo_); o[dt] = mfma32(vf_, pf_, o[dt]); } } } while (0)
    if (act) {
        f32x16 sA, sB;
        QKT(sA, 0);
#pragma unroll 1
        for (int i = 0; i < nst; i += 2) {
            if (i + 1 < nst) QKT(sB, i + 1);
            SOFT(sA, i); PVT(sA, i);
            if (i + 1 < nst) {
                if (i + 2 < nst) QKT(sA, i + 2);
                SOFT(sB, i + 1); PVT(sB, i + 1);
            }
        }
    }
#undef QKT
#undef SOFT
#undef PVT
    } else {
    const LAS unsigned char* kq = lds + AT_KS + q * 256;
    const LAS unsigned char* vq = lds + AT_VT + q * 512;
#define QK64(S, s_) do { const LAS unsigned char* kp_ = kq + (s_) * (64 * 256); \
        _Pragma("unroll") for (int kt = 0; kt < 2; ++kt) { _Pragma("unroll") for (int r = 0; r < 16; ++r) S[kt][r] = 0.f; \
            _Pragma("unroll") for (int ds = 0; ds < 8; ++ds) { const bf16x8 kf_ = *(const LAS bf16x8*)(kp_ + kt * (32 * 256) + (((2 * ds) ^ sw) << 4)); S[kt] = mfma32(kf_, qf[ds], S[kt]); } } } while (0)
#define SOFT64(S, s_) do { const int d0_ = qpos - (n * MBLK + 64 * (s_) + 4 * hi); \
        const bool far_ = (__all(d0_ - 63 >= 128) != 0); \
        float alpha_, ps_ = 0.f; \
        if (far_) { const float c_ = TAB[128]; \
            float mr_ = fmaxf(fmaxf(S[0][0], S[0][1]), S[0][2]); \
            _Pragma("unroll") for (int r = 3; r < 16; ++r) mr_ = fmaxf(mr_, S[0][r]); \
            _Pragma("unroll") for (int r = 0; r < 16; ++r) mr_ = fmaxf(mr_, S[1][r]); \
            mr_ = fmaxf(mr_, __shfl_xor(mr_, 32)); \
            const float mn_ = fmaxf(m, mr_ * QK_C1 + c_); alpha_ = __builtin_amdgcn_exp2f(m - mn_); m = mn_; \
            const float cm_ = c_ - mn_; \
            _Pragma("unroll") for (int kt = 0; kt < 2; ++kt) _Pragma("unroll") for (int r = 0; r < 16; ++r) { const float p_ = __builtin_amdgcn_exp2f(__builtin_fmaf(S[kt][r], QK_C1, cm_)); S[kt][r] = p_; ps_ += p_; } \
        } else { \
            _Pragma("unroll") for (int kt = 0; kt < 2; ++kt) _Pragma("unroll") for (int r = 0; r < 16; ++r) { const int dist_ = d0_ - (32 * kt + (r & 3) + 8 * (r >> 2)); \
                const int di_ = dist_ < 0 ? 0 : (dist_ > 128 ? 128 : dist_); S[kt][r] = S[kt][r] * QK_C1 + TAB[di_]; } \
            float mt_ = S[0][0]; \
            _Pragma("unroll") for (int r = 1; r < 16; ++r) mt_ = fmaxf(mt_, S[0][r]); \
            _Pragma("unroll") for (int r = 0; r < 16; ++r) mt_ = fmaxf(mt_, S[1][r]); \
            mt_ = fmaxf(mt_, __shfl_xor(mt_, 32)); \
            const float mn_ = fmaxf(m, mt_); alpha_ = __builtin_amdgcn_exp2f(m - mn_); m = mn_; \
            _Pragma("unroll") for (int kt = 0; kt < 2; ++kt) _Pragma("unroll") for (int r = 0; r < 16; ++r) { const float p_ = __builtin_amdgcn_exp2f(S[kt][r] - mn_); S[kt][r] = p_; ps_ += p_; } \
        } \
        l = l * alpha_ + ps_; \
        if (__any(alpha_ != 1.f)) { _Pragma("unroll") for (int dt = 0; dt < 4; ++dt) _Pragma("unroll") for (int r = 0; r < 16; ++r) o[dt][r] *= alpha_; } } while (0)
#define PV64(S, s_) do { _Pragma("unroll") for (int j = 0; j < 4; ++j) { \
            v4u pw_; pw_.x = pk2(S[j >> 1][8 * (j & 1) + 0], S[j >> 1][8 * (j & 1) + 1]); pw_.y = pk2(S[j >> 1][8 * (j & 1) + 2], S[j >> 1][8 * (j & 1) + 3]); \
            pw_.z = pk2(S[j >> 1][8 * (j & 1) + 4], S[j >> 1][8 * (j & 1) + 5]); pw_.w = pk2(S[j >> 1][8 * (j & 1) + 6], S[j >> 1][8 * (j & 1) + 7]); \
            const bf16x8 pf_ = __builtin_bit_cast(bf16x8, pw_); \
            const int vo_ = ((8 * (s_) + 2 * j) ^ sw) << 4; \
            _Pragma("unroll") for (int dt = 0; dt < 4; ++dt) { const bf16x8 vf_ = *(const LAS bf16x8*)(vq + dt * (32 * 512) + vo_); o[dt] = mfma32(vf_, pf_, o[dt]); } } } while (0)
    if (act) {
        f32x16 tA[2], tB[2];
        QK64(tA, 0);
#pragma unroll 1
        for (int s = 0; s < 4; s += 2) {
            QK64(tB, s + 1); SOFT64(tA, s); PV64(tA, s);
            if (s + 2 < 4) QK64(tA, s + 2);
            SOFT64(tB, s + 1); PV64(tB, s + 1);
        }
    }
#undef QK64
#undef SOFT64
#undef PV64
    }
    if (has_next) moba_load_q(a, b, h, e_next, hi, qf);
    if (!act) return;
    const float ltot = l + __shfl_xor(l, 32);
    const size_t tok = (size_t)b * SEQ + qpos;
    const size_t pe0 = (tok * MH + h) * 3;
    bf16* PART = (bf16*)(a.ws + WS_PART); f32x2_t* ML = (f32x2_t*)(a.ws + WS_ML);
    if (!OWN) {
        if (valid) {
            const float inv = 1.f / ltot;
            bf16* pp = PART + (pe0 + slot) * MDH + 8 * hi;
#pragma unroll
            for (int dt = 0; dt < 4; ++dt)
#pragma unroll
                for (int g = 0; g < 4; g += 2) {
                    unsigned ax = pk2(o[dt][4 * g] * inv, o[dt][4 * g + 1] * inv), ay = pk2(o[dt][4 * g + 2] * inv, o[dt][4 * g + 3] * inv);
                    unsigned bx = pk2(o[dt][4 * g + 4] * inv, o[dt][4 * g + 5] * inv), by = pk2(o[dt][4 * g + 6] * inv, o[dt][4 * g + 7] * inv);
                    { auto r = __builtin_amdgcn_permlane32_swap(ax, bx, false, false); ax = r[0]; bx = r[1]; }
                    { auto r = __builtin_amdgcn_permlane32_swap(ay, by, false, false); ay = r[0]; by = r[1]; }
                    *(v4u*)(pp + 32 * dt + 8 * g) = (v4u){ax, ay, bx, by};
                }
            if (hi == 0) ML[pe0 + slot] = (f32x2_t){m, ltot};
        }
    } else {
        const int nsel = n < MTOPK ? n : MTOPK;
        f32x2_t ml0 = {-INFINITY, 0.f}, ml1 = {-INFINITY, 0.f}, ml2 = {-INFINITY, 0.f};
        if (nsel > 0) ml0 = ML[pe0 + 0];
        if (nsel > 1) ml1 = ML[pe0 + 1];
        if (nsel > 2) ml2 = ML[pe0 + 2];
        const float M = fmaxf(fmaxf(m, ml0.x), fmaxf(ml1.x, ml2.x));
        const float wo = __builtin_amdgcn_exp2f(m - M);
        const float w0 = ml0.y * __builtin_amdgcn_exp2f(ml0.x - M), w1 = ml1.y * __builtin_amdgcn_exp2f(ml1.x - M), w2 = ml2.y * __builtin_amdgcn_exp2f(ml2.x - M);
        const float inv = 1.f / (ltot * wo + w0 + w1 + w2);
        const bf16* pp = PART + pe0 * MDH + 8 * hi;
        bf16* op = (bf16*)(a.ws + WS_S) + tok * (MH * MDH) + h * MDH + 8 * hi;
#pragma unroll
        for (int dt = 0; dt < 4; ++dt)
#pragma unroll
            for (int g = 0; g < 4; g += 2) {
                float x[8];
#pragma unroll
                for (int i = 0; i < 8; ++i) x[i] = o[dt][4 * g + i] * wo;
#define MOBA_MERGE(SL, W) do { v4u p = *(const v4u*)(pp + (SL) * MDH + 32 * dt + 8 * g); \
                    { auto r = __builtin_amdgcn_permlane32_swap(p.x, p.z, false, false); p.x = r[0]; p.z = r[1]; } \
                    { auto r = __builtin_amdgcn_permlane32_swap(p.y, p.w, false, false); p.y = r[0]; p.w = r[1]; } \
                    x[0] += (W) * lo_bf(p.x); x[1] += (W) * hi_bf(p.x); x[2] += (W) * lo_bf(p.y); x[3] += (W) * hi_bf(p.y); \
                    x[4] += (W) * lo_bf(p.z); x[5] += (W) * hi_bf(p.z); x[6] += (W) * lo_bf(p.w); x[7] += (W) * hi_bf(p.w); } while (0)
                if (nsel > 0) MOBA_MERGE(0, w0);
                if (nsel > 1) MOBA_MERGE(1, w1);
                if (nsel > 2) MOBA_MERGE(2, w2);
#undef MOBA_MERGE
                unsigned ax = pk2(x[0] * inv, x[1] * inv), ay = pk2(x[2] * inv, x[3] * inv), bx = pk2(x[4] * inv, x[5] * inv), by = pk2(x[6] * inv, x[7] * inv);
                { auto r = __builtin_amdgcn_permlane32_swap(ax, bx, false, false); ax = r[0]; bx = r[1]; }
                { auto r = __builtin_amdgcn_permlane32_swap(ay, by, false, false); ay = r[0]; by = r[1]; }
                *(v4u*)(op + 32 * dt + 8 * g) = (v4u){ax, ay, bx, by};
            }
    }
}

__device__ __forceinline__ void moba_sel_phase(const Args& a, LAS unsigned char* lds, int tid, int lane, int wave, int vcu, int G) {
    LAS unsigned* CNT = (LAS unsigned*)(lds + AT_CNT); LAS unsigned* PRE = (LAS unsigned*)(lds + AT_PRE);
    { const gu32* mc = (const gu32*)(a.ws + WS_CTL) + CW_MCNT; CNT[tid] = __hip_atomic_load(mc + tid, RLX_AGENT); }
    __syncthreads();
    if (wave == 0) {
        unsigned loc = 0;
#pragma unroll
        for (int i = 0; i < 8; ++i) loc += (CNT[lane * 8 + i] + 255u) >> 8;
        unsigned inc = loc;
#pragma unroll
        for (int o = 1; o < 64; o <<= 1) { const unsigned v = __shfl_up(inc, o); if (lane >= o) inc += v; }
        unsigned run = inc - loc;
#pragma unroll
        for (int i = 0; i < 8; ++i) { PRE[lane * 8 + i] = run; run += (CNT[lane * 8 + i] + 255u) >> 8; }
        if (lane == 63) PRE[512] = run;
    }
    __syncthreads();
    const int T = (int)PRE[512];
    const int lo = (int)(((long)vcu * T) / G), hi = (int)(((long)(vcu + 1) * T) / G);
    for (int L = 0; L < BATCH * MH * NBLK; ++L) {
        const int s = (int)PRE[L], cnt = (int)CNT[L], nt = (cnt + 255) >> 8;
        const int t0 = lo > s ? lo - s : 0, t1 = (hi - s) < nt ? (hi - s) : nt;
        if (t0 >= t1) continue;
        const int bh = L >> 5, n = L & 31, b = bh >> 2, h = bh & 3;
        moba_stage_kv(a, lds, b, h, n, tid);
        __syncthreads();
        const unsigned short* list = (const unsigned short*)(a.ws + WS_LIST) + (size_t)bh * LIST_PER_BH + list_off(n);
        {
            const int t0u = __builtin_amdgcn_readfirstlane(t0), t1u = __builtin_amdgcn_readfirstlane(t1), cntu = __builtin_amdgcn_readfirstlane(cnt);
            const int rl = 32 * wave + (lane & 31);
            bf16x8 qf[8];
            unsigned e; { const int ridx = 256 * t0u + rl; e = ridx < cntu ? (unsigned)list[ridx] : 0x80001fffu; }
            moba_load_q(a, b, h, e, lane >> 5, qf);
            for (int t = t0u; t < t1u; ++t) {
                unsigned en = e; const bool hn = t + 1 < t1u;
                if (hn) { const int ridx = 256 * (t + 1) + rl; en = ridx < cntu ? (unsigned)list[ridx] : 0x80001fffu; }
                moba_wave_tile<false>(a, lds, b, h, n, e, qf, en, hn, lane, wave);
                e = en;
            }
        }
        __syncthreads();
    }
}
__device__ __forceinline__ void moba_own_phase(const Args& a, LAS unsigned char* lds, int tid, int lane, int wave, int vcu, int G) {
    for (int u = vcu; u < BATCH * MH * NBLK; u += G) {
        const int bh = u >> 5, n = u & 31, b = bh >> 2, h = bh & 3;
        moba_stage_kv(a, lds, b, h, n, tid);
        __syncthreads();
        { bf16x8 qf[8]; const unsigned e = (unsigned)(n * MBLK + 32 * wave + (lane & 31)); moba_load_q(a, b, h, e, lane >> 5, qf);
          moba_wave_tile<true>(a, lds, b, h, n, e, qf, e, false, lane, wave); }
        __syncthreads();
    }
}

__device__ __forceinline__ void transpose_item(const float* W, int K, int N, bf16* WT, int mode, int thr, int add, LAS float* scr, int item, int lane, int ldt = 0, int koff = 0) {
    if (ldt == 0) ldt = K;
    const int nblk = (N + 31) / 32, kb = item / nblk, nb = item % nblk, k0 = 64 * kb, n0 = 32 * nb;
    const int c4 = 4 * (lane & 7), nc = n0 + c4;
    f32x4 v[8];
#pragma unroll
    for (int i = 0; i < 8; ++i) { const int kk = 8 * i + (lane >> 3); v[i] = nc < N ? *(const f32x4*)(W + (size_t)(k0 + kk) * N + nc) : (f32x4){0.f, 0.f, 0.f, 0.f}; }
#pragma unroll
    for (int i = 0; i < 8; ++i) { const int kk = 8 * i + (lane >> 3); LAS float* s = scr + kk * 33 + c4; s[0] = v[i][0]; s[1] = v[i][1]; s[2] = v[i][2]; s[3] = v[i][3]; }
    LDS_WAIT(); asm volatile("" ::: "memory");
    const int c = lane & 7;
#pragma unroll
    for (int j = 0; j < 4; ++j) { const int nl = (lane >> 3) + 8 * j, n = n0 + nl; const LAS float* s = scr + (8 * c) * 33 + nl;
        v4u o; o.x = pk2(s[0 * 33], s[1 * 33]); o.y = pk2(s[2 * 33], s[3 * 33]); o.z = pk2(s[4 * 33], s[5 * 33]); o.w = pk2(s[6 * 33], s[7 * 33]);
        const int drow = mode == 0 ? (n + (n >= thr ? add : 0)) : mode == 1 ? (256 * (n >> 7) + (n & 127) + add)
                       : (n < S_GLR ? n : n < S_GOG ? -1 : n < S_GA ? n - (S_GOG - S_GLR) : n - S_GA + PMN);
        if (n < N && drow >= 0) *(GAS v4u*)(WT + (size_t)drow * ldt + koff + k0 + 8 * c) = o; }
    LDS_WAIT(); asm volatile("" ::: "memory");
}

__device__ __forceinline__ void phase_p0(const Args& a, LAS unsigned char* lds, int tid, int lane, int wave, int vcu, int G) {
    unsigned char* ws = a.ws;
    float* mod = (float*)(ws + WS_MOD);
    for (int item = vcu; item < (NMOD * D) / 64; item += G) {
        LAS float* sc = (LAS float*)lds;
        for (int i = tid; i < BATCH * D; i += NWAVES * 64) sc[i] = silu_f(a.in[I_C][i]);
        __syncthreads();
        const int j = item * 64 + lane;
        float acc0 = 0.f, acc1 = 0.f, acc2 = 0.f, acc3 = 0.f;
        const float* wp = a.in[I_WADA] + (size_t)(wave * 128) * (NMOD * D) + j;
#pragma unroll 32
        for (int k = 0; k < 128; ++k) { const float w = wp[(size_t)k * (NMOD * D)]; const int kk = wave * 128 + k;
            acc0 += sc[kk] * w; acc1 += sc[D + kk] * w; acc2 += sc[2 * D + kk] * w; acc3 += sc[3 * D + kk] * w; }
        LAS float* red = (LAS float*)(lds + 16384);
        red[(wave * 4 + 0) * 64 + lane] = acc0; red[(wave * 4 + 1) * 64 + lane] = acc1; red[(wave * 4 + 2) * 64 + lane] = acc2; red[(wave * 4 + 3) * 64 + lane] = acc3;
        __syncthreads();
        if (wave < 4) { float s = 0.f;
#pragma unroll
            for (int w = 0; w < NWAVES; ++w) s += red[(w * 4 + wave) * 64 + lane];
            mod[wave * (NMOD * D) + j] = s + a.in[I_BADA][j]; }
        __syncthreads();
    }
    LAS float* scr = (LAS float*)(lds + RING_OFF + wave * 16384);
    const int gw = vcu * NWAVES + wave, NGW = G * NWAVES;
    constexpr int I_FU = (D / 64) * (FF / 32), I_FD = (FF / 64) * (D / 32), I_IN = (D / 64) * ((INW + 31) / 32), I_BR = (512 / 64) * (D / 32), I_OUT = (D / 64) * (D / 32);
    constexpr int NITEMS = 2 * I_FU + I_FD + I_IN + 2 * I_BR + I_OUT;
    for (int it = gw; it < NITEMS; it += NGW) {
        int r = it;
        if (r < I_FU) { transpose_item(a.in[I_W1G], D, FF, (bf16*)(ws + WS_W1GU), 1, 0, 0, scr, r, lane); continue; } r -= I_FU;
        if (r < I_FU) { transpose_item(a.in[I_W1U], D, FF, (bf16*)(ws + WS_W1GU), 1, 0, 128, scr, r, lane); continue; } r -= I_FU;
        if (r < I_FD) { transpose_item(a.in[I_W1D], FF, D, (bf16*)(ws + WS_W1D), 0, 1 << 30, 0, scr, r, lane); continue; } r -= I_FD;
        if (r < I_IN) { transpose_item(a.in[I_WIN], D, INW, (bf16*)(ws + WS_WIN), 2, 0, 0, scr, r, lane); continue; } r -= I_IN;
        if (r < I_BR) { transpose_item(a.in[I_WBRA], 512, D, (bf16*)(ws + WS_WBRA), 0, 1 << 30, 0, scr, r, lane, D, 0); continue; } r -= I_BR;
        if (r < I_BR) { transpose_item(a.in[I_WBRB], 512, D, (bf16*)(ws + WS_WBRA), 0, 1 << 30, 0, scr, r, lane, D, 512); continue; } r -= I_BR;
        transpose_item(a.in[I_WOUT], D, D, (bf16*)(ws + WS_WOUT), 0, 1 << 30, 0, scr, r, lane);
    }
    for (int it = gw * 64 + lane; it < (GH * GDK) * (D / 8); it += NGW * 64) {
        const int j = it >> 7, k0 = (it & 127) * 8;
        float wl[16];
#pragma unroll
        for (int r = 0; r < 16; ++r) wl[r] = a.in[I_WLR][r * (GH * GDK) + j];
        float o[8];
#pragma unroll
        for (int kk = 0; kk < 8; ++kk) { const float* p = a.in[I_WIN] + (size_t)(k0 + kk) * INW + S_GLR;
            const f32x4 x0 = *(const f32x4*)p, x1 = *(const f32x4*)(p + 4), x2 = *(const f32x4*)(p + 8), x3 = *(const f32x4*)(p + 12);
            o[kk] = ((x0[0] * wl[0] + x0[1] * wl[1]) + (x0[2] * wl[2] + x0[3] * wl[3])) + ((x1[0] * wl[4] + x1[1] * wl[5]) + (x1[2] * wl[6] + x1[3] * wl[7]))
                  + ((x2[0] * wl[8] + x2[1] * wl[9]) + (x2[2] * wl[10] + x2[3] * wl[11])) + ((x3[0] * wl[12] + x3[1] * wl[13]) + (x3[2] * wl[14] + x3[3] * wl[15])); }
        v4u w; w.x = pk2(o[0], o[1]); w.y = pk2(o[2], o[3]); w.z = pk2(o[4], o[5]); w.w = pk2(o[6], o[7]);
        *(GAS v4u*)((bf16*)(ws + WS_WIN) + (size_t)(O_Z + j) * D + k0) = w;
    }
}

__device__ __forceinline__ void convert_ffn2(const Args& a, LAS unsigned char* lds, int lane, int wave, int vi, int nv) {
    unsigned char* ws = a.ws;
    LAS float* scr = (LAS float*)(lds + RING_OFF + wave * 16384);
    constexpr int I_FU = (D / 64) * (FF / 32), I_FD = (FF / 64) * (D / 32);
    for (int it = vi * NWAVES + wave; it < 2 * I_FU + I_FD; it += nv * NWAVES) {
        int r = it;
        if (r < I_FU) { transpose_item(a.in[I_W2G], D, FF, (bf16*)(ws + WS_W2GU), 1, 0, 0, scr, r, lane); continue; } r -= I_FU;
        if (r < I_FU) { transpose_item(a.in[I_W2U], D, FF, (bf16*)(ws + WS_W2GU), 1, 0, 128, scr, r, lane); continue; } r -= I_FU;
        transpose_item(a.in[I_W2D], FF, D, (bf16*)(ws + WS_W2D), 0, 1 << 30, 0, scr, r, lane);
    }
}

__device__ __forceinline__ void phase_norm_mod(const float* h, const float* g, const float* mod_sh, const float* mod_sc, bf16* u, int lane, int wave, int vcu, int G) {
    const int gw = vcu * NWAVES + wave, NGW = G * NWAVES, rpw = 16;
    for (int r0 = gw * rpw; r0 < MTOK; r0 += NGW * rpw) {
    const int b = r0 / SEQ;
    f32x4 cs[4], sh[4];
#pragma unroll
    for (int j = 0; j < 4; ++j) { const int c = 4 * (lane + 64 * j);
        const f32x4 gg = *(const f32x4*)(g + c), s = *(const f32x4*)(mod_sc + (size_t)b * (NMOD * D) + c);
        cs[j] = gg * (s + 1.0f); sh[j] = *(const f32x4*)(mod_sh + (size_t)b * (NMOD * D) + c); }
    for (int r = r0; r < r0 + rpw; ++r) {
        const GAS f32x4* xr = (const GAS f32x4*)(h + (size_t)r * D) + lane;
        f32x4 v[4]; float s = 0.f;
#pragma unroll
        for (int j = 0; j < 4; ++j) { v[j] = xr[64 * j]; s += (v[j].x * v[j].x + v[j].y * v[j].y) + (v[j].z * v[j].z + v[j].w * v[j].w); }
        const float rstd = rsqrtf(wave_sum(s) * (1.f / D) + EPS);
        GAS v2u* o8 = (GAS v2u*)(u + (size_t)r * D) + lane;
#pragma unroll
        for (int j = 0; j < 4; ++j) { const f32x4 y = v[j] * rstd * cs[j] + sh[j]; v2u w; w.x = pk2(y.x, y.y); w.y = pk2(y.z, y.w); o8[64 * j] = w; }
    }
    }
}
__device__ __forceinline__ void row16_bf(const bf16* p, int lane, float (&v)[16]) {
    const v4u a = *(const v4u*)(p + 8 * lane), c = *(const v4u*)(p + 512 + 8 * lane);
    v[0] = lo_bf(a.x); v[1] = hi_bf(a.x); v[2] = lo_bf(a.y); v[3] = hi_bf(a.y); v[4] = lo_bf(a.z); v[5] = hi_bf(a.z); v[6] = lo_bf(a.w); v[7] = hi_bf(a.w);
    v[8] = lo_bf(c.x); v[9] = hi_bf(c.x); v[10] = lo_bf(c.y); v[11] = hi_bf(c.y); v[12] = lo_bf(c.z); v[13] = hi_bf(c.z); v[14] = lo_bf(c.w); v[15] = hi_bf(c.w);
}
__device__ __forceinline__ void vec16_f(const float* p, int lane, float (&v)[16]) {
#pragma unroll
    for (int j = 0; j < 2; ++j) { const f32x4 a = *(const f32x4*)(p + 512 * j + 8 * lane), c = *(const f32x4*)(p + 512 * j + 8 * lane + 4);
        v[8 * j] = a[0]; v[8 * j + 1] = a[1]; v[8 * j + 2] = a[2]; v[8 * j + 3] = a[3]; v[8 * j + 4] = c[0]; v[8 * j + 5] = c[1]; v[8 * j + 6] = c[2]; v[8 * j + 7] = c[3]; }
}
__device__ __forceinline__ void phase_norm_mod_b(const bf16* h, const float* g, const float* mod_sh, const float* mod_sc, bf16* u, int lane, int wave, int vcu, int G) {
    const int gw = vcu * NWAVES + wave, NGW = G * NWAVES, rpw = 16;
    for (int r0 = gw * rpw; r0 < MTOK; r0 += NGW * rpw) {
    const int b = r0 / SEQ;
    float cs[16], sh[16];
    { float gg[16], ss[16]; vec16_f(g, lane, gg); vec16_f(mod_sc + (size_t)b * (NMOD * D), lane, ss); vec16_f(mod_sh + (size_t)b * (NMOD * D), lane, sh);
#pragma unroll
      for (int i = 0; i < 16; ++i) cs[i] = gg[i] * (ss[i] + 1.0f); }
    for (int r = r0; r < r0 + rpw; ++r) {
        float v[16]; row16_bf(h + (size_t)r * D, lane, v);
        float s = 0.f;
#pragma unroll
        for (int i = 0; i < 16; ++i) s += v[i] * v[i];
        const float rstd = rsqrtf(wave_sum(s) * (1.f / D) + EPS);
#pragma unroll
        for (int j = 0; j < 2; ++j) { v4u w;
            w.x = pk2(v[8 * j] * rstd * cs[8 * j] + sh[8 * j], v[8 * j + 1] * rstd * cs[8 * j + 1] + sh[8 * j + 1]); w.y = pk2(v[8 * j + 2] * rstd * cs[8 * j + 2] + sh[8 * j + 2], v[8 * j + 3] * rstd * cs[8 * j + 3] + sh[8 * j + 3]);
            w.z = pk2(v[8 * j + 4] * rstd * cs[8 * j + 4] + sh[8 * j + 4], v[8 * j + 5] * rstd * cs[8 * j + 5] + sh[8 * j + 5]); w.w = pk2(v[8 * j + 6] * rstd * cs[8 * j + 6] + sh[8 * j + 6], v[8 * j + 7] * rstd * cs[8 * j + 7] + sh[8 * j + 7]);
            *(v4u*)(u + (size_t)r * D + 512 * j + 8 * lane) = w; }
    }
    }
}
__device__ __forceinline__ void phase_final_norm(const bf16* h, float* out, const float* g, int lane, int wave, int vcu, int G) {
    const int gw = vcu * NWAVES + wave, NGW = G * NWAVES, rpw = 16;
    float cs[16]; vec16_f(g, lane, cs);
    for (int r0 = gw * rpw; r0 < MTOK; r0 += NGW * rpw)
    for (int r = r0; r < r0 + rpw; ++r) {
        float v[16]; row16_bf(h + (size_t)r * D, lane, v);
        float s = 0.f;
#pragma unroll
        for (int i = 0; i < 16; ++i) s += v[i] * v[i];
        const float rstd = rsqrtf(wave_sum(s) * (1.f / D) + EPS);
#pragma unroll
        for (int j = 0; j < 2; ++j) { float* o = out + (size_t)r * D + 512 * j + 8 * lane;
            *(f32x4*)o = (f32x4){v[8 * j] * rstd * cs[8 * j], v[8 * j + 1] * rstd * cs[8 * j + 1], v[8 * j + 2] * rstd * cs[8 * j + 2], v[8 * j + 3] * rstd * cs[8 * j + 3]};
            *(f32x4*)(o + 4) = (f32x4){v[8 * j + 4] * rstd * cs[8 * j + 4], v[8 * j + 5] * rstd * cs[8 * j + 5], v[8 * j + 6] * rstd * cs[8 * j + 6], v[8 * j + 7] * rstd * cs[8 * j + 7]}; }
    }
}

constexpr int NPHASE = 17;
__global__ void __launch_bounds__(NWAVES * 64, 2) mega_fwd(Args args) {
    extern __shared__ __attribute__((aligned(16))) unsigned char lds_raw[];
    LAS unsigned char* lds = (LAS unsigned char*)lds_raw;
    volatile LAS unsigned* MISC = (volatile LAS unsigned*)(lds + MISC_OFF);
    const int wave = __builtin_amdgcn_readfirstlane((int)threadIdx.x >> 6);
    int lane = (int)threadIdx.x & 63, tid = (int)threadIdx.x;
#define REFRESH_IDS() (lane = (int)__builtin_amdgcn_mbcnt_hi(~0u, __builtin_amdgcn_mbcnt_lo(~0u, 0u)), tid = wave * 64 + lane, true)
    const int G = gridDim.x; const int bx = blockIdx.x; const int vcu = (G % 8 == 0) ? (bx % 8) * (G / 8) + bx / 8 : bx;
    unsigned char* ws = args.ws;
    gu32* ctl = (gu32*)(ws + WS_CTL);
    for (int u = tid; u < (LDS_BYTES - LDSCTL_OFF) / 4; u += NWAVES * 64) ((LAS unsigned*)(lds + LDSCTL_OFF))[u] = 0u;
    __syncthreads();
    XcdBarrier bar = xcd_barrier_post((unsigned*)(ctl + CW_BAR) + args.li * XCD_BAR_WORDS, MISC + 8);
    const unsigned pmask = (unsigned)args.ph_mask;
#define IN(k) ((pmask >> (k)) & 1u)
#define SEAM(k) do { if (IN(k) && (pmask >> ((k) + 1)) != 0u) xcd_barrier(bar); } while (0)
    float* mod = (float*)(ws + WS_MOD);
    bf16* U = (bf16*)(ws + WS_U); bf16* BIG = (bf16*)(ws + WS_BIG); bf16* MERGED = (bf16*)(ws + WS_PART);
    bf16* OA = (bf16*)(ws + WS_OA); bf16* OB = (bf16*)(ws + WS_S);
    bf16* HB = args.li ? (bf16*)(ws + WS_PART) : (bf16*)args.out;
    float* OUT = args.li ? (float*)(ws + WS_PART) : args.out;
    unsigned char* G8 = (args.li ? (unsigned char*)(ws + WS_PART) : (unsigned char*)args.out) + (size_t)MTOK * D * 2;

#define PH(k) if (IN(k) && ((ONLYMASK >> (k)) & 1) && REFRESH_IDS())

    PH(0) phase_p0(args, lds, tid, lane, wave, vcu, G);
    SEAM(0);
    PH(1) phase_norm_mod(args.in[I_X], args.in[I_NFF1], mod + 0 * D, mod + 1 * D, U, lane, wave, vcu, G);
    SEAM(1);
    PH(2) { pg8::Gemm g{U, (const bf16*)(ws + WS_W1GU), MTOK, 2 * FF, D}; pg8::StaticOrder S; S.init(MTOK, 2 * FF, G, bx);
        pg8::EpiSwiGLU E{BIG, FF, 0}; pg8::gemm_phase<pg8::EpiSwiGLU, pg8::StaticOrder, true, true>(lds + RING_OFF, g, S, E, tid); }
    SEAM(2);
    PH(3) { pg8::Gemm g{BIG, (const bf16*)(ws + WS_W1D), MTOK, D, FF}; pg8::StaticOrder S; S.init(MTOK, D, G, bx);
        pg8::EpiResid<false> E{args.in[I_X], HB, mod + 2 * D, 0.5f}; pg8::gemm_phase<pg8::EpiResid<false>, pg8::StaticOrder, true, true>(lds + RING_OFF, g, S, E, tid); }
    SEAM(3);
    PH(4) phase_norm_mod_b(HB, args.in[I_NMIX], mod + 3 * D, mod + 4 * D, U, lane, wave, vcu, G);
    SEAM(4);
    PH(5) { pg8::Gemm g{U, (const bf16*)(ws + WS_WIN), MTOK, PJN, D}; pg8::StaticOrder S; S.init(MTOK, PJN, G, bx);
        pg8::EpiProj E{BIG, G8, args.in[I_BLR]}; pg8::gemm_phase<pg8::EpiProj, pg8::StaticOrder, true, true>(lds + RING_OFF, g, S, E, tid);
        { const int nwg = (MTOK / 256) * (PJN / 256), rem = nwg % G;
          if (rem == 0) convert_ffn2(args, lds, lane, wave, bx, G); else if (bx >= rem) convert_ffn2(args, lds, lane, wave, bx - rem, G - rem); } }
    SEAM(5);
    PH(6) { if (args.li != 3) gla_local_phase(args, lds, tid, lane, wave, vcu, G);
        if (args.li != 4) for (int u = vcu; u < BATCH * MH * NBLK; u += G) moba_prep_unit(args, lds, u, tid); }
    SEAM(6);
    PH(7) { if (args.li != 3 && tid < 256) for (int gt = vcu * 256 + tid; gt < 65536; gt += G * 256) gla_scan(args, gt);
        if (args.li != 4) for (int u = vcu; u < BATCH * MH * (NBLK - 1); u += G) moba_topk_unit(args, lds, u, tid); }
    SEAM(7);
    PH(8) {
#ifndef NO_GLA_OUT
        if (args.li != 3) gla_out_phase(args, lds, tid, lane, wave, vcu, G);
#endif
#ifndef NO_SEL
        if (args.li != 4) moba_sel_phase(args, lds, tid, lane, wave, vcu, G);
#endif
    }
    SEAM(8);
    PH(9) moba_own_phase(args, lds, tid, lane, wave, vcu, G);
    SEAM(9);
    SEAM(10);
    PH(11) { pg8::Gemm g{OA, (const bf16*)(ws + WS_WBRA), MTOK, D, D, OB, 512, 8}; pg8::StaticOrder S; S.init(MTOK, D, G, bx);
        pg8::EpiGateCat E{MERGED, G8}; pg8::gemm_phase<pg8::EpiGateCat, pg8::StaticOrder, true, true>(lds + RING_OFF, g, S, E, tid); }
    SEAM(11);
    PH(12) { pg8::Gemm g{MERGED, (const bf16*)(ws + WS_WOUT), MTOK, D, D}; pg8::StaticOrder S; S.init(MTOK, D, G, bx);
        pg8::EpiResid<true> E{HB, HB, mod + 5 * D, 1.0f}; pg8::gemm_phase<pg8::EpiResid<true>, pg8::StaticOrder, true, true>(lds + RING_OFF, g, S, E, tid); }
    SEAM(12);
    PH(13) phase_norm_mod_b(HB, args.in[I_NFF2], mod + 6 * D, mod + 7 * D, U, lane, wave, vcu, G);
    SEAM(13);
    PH(14) { pg8::Gemm g{U, (const bf16*)(ws + WS_W2GU), MTOK, 2 * FF, D}; pg8::StaticOrder S; S.init(MTOK, 2 * FF, G, bx);
        pg8::EpiSwiGLU E{BIG, FF, 0}; pg8::gemm_phase<pg8::EpiSwiGLU, pg8::StaticOrder, true, true>(lds + RING_OFF, g, S, E, tid); }
    SEAM(14);
    PH(15) { pg8::Gemm g{BIG, (const bf16*)(ws + WS_W2D), MTOK, D, FF}; pg8::StaticOrder S; S.init(MTOK, D, G, bx);
        pg8::EpiResid<true> E{HB, U, mod + 8 * D, 0.5f}; pg8::gemm_phase<pg8::EpiResid<true>, pg8::StaticOrder, true, true>(lds + RING_OFF, g, S, E, tid); }
    SEAM(15);
    PH(16) phase_final_norm(U, OUT, args.in[I_NFIN], lane, wave, vcu, G);
    SEAM(17); SEAM(18); SEAM(19); SEAM(20); SEAM(21); SEAM(22); SEAM(23); SEAM(24);
#undef IN
#undef PH
#undef SEAM
}

extern "C" void kernel_launch(void* const* d_in, const int* in_sizes, int n_in, void* d_out, int out_size, void* d_ws, size_t ws_size, hipStream_t stream) {
    static int grid = 0;
    if (grid == 0) {
        if (n_in != 22 || out_size != MTOK * D || ws_size < WS_END) { fprintf(stderr, "kernel_launch: unexpected problem (n_in %d out %d ws %zu)\n", n_in, out_size, ws_size); grid = -1; return; }
        int dev = 0, cus = 0;
        if (hipGetDevice(&dev) != hipSuccess || hipDeviceGetAttribute(&cus, hipDeviceAttributeMultiprocessorCount, dev) != hipSuccess) { grid = -1; return; }
        if (hipFuncSetAttribute((const void*)mega_fwd, hipFuncAttributeMaxDynamicSharedMemorySize, LDS_BYTES) != hipSuccess) { grid = -1; return; }
        grid = cus;
    }
    if (grid < 0) return;
    (void)hipMemsetAsync((char*)d_ws + WS_CTL, 0, CTL_ZERO_BYTES, stream);
    Args a{};
    for (int i = 0; i < 22; ++i) a.in[i] = (const float*)d_in[i];
    a.out = (float*)d_out; a.ws = (unsigned char*)d_ws;
    unsigned char* ws = (unsigned char*)d_ws;
    a.ph_mask = ((1 << NPHASE) - 1) & ~(1 << 10); a.li = 0;
    hipLaunchKernelGGL(mega_fwd, dim3(grid), dim3(NWAVES * 64), LDS_BYTES, stream, a);
#if PROBEMASK
    a.ph_mask = PROBEMASK; a.li = PROBELI;
    hipLaunchKernelGGL(mega_fwd, dim3(grid), dim3(NWAVES * 64), LDS_BYTES, stream, a);
#endif
}
```

```cpp
#include <hip/hip_runtime.h>
#include <cstdio>
#include <cstdint>
#ifndef PROBEMASK
#define PROBEMASK 0
#endif
#ifndef PROBELI
#define PROBELI 1
#endif
#ifndef PROBEX
#define PROBEX 0
#endif
#ifndef ONLYMASK
#define ONLYMASK 0x1ffff
#endif

constexpr int D = 1024, BATCH = 4, SEQ = 8192, MTOK = BATCH * SEQ;
constexpr int GH = 4, GDK = 64, GDV = 128, GLR = 16;
constexpr int MH = 4, MDH = 128, MBLK = 256, MTOPK = 3, NBLK = SEQ / MBLK;
constexpr int FF = 2816, NMOD = 9;
constexpr int INW = 5136;
constexpr int S_GLR = 1024, S_GOG = 1040, S_GA = 3088;
constexpr int O_GQ = 0, O_GK = 256, O_GV = 512, O_GOG = 1024, O_MQ = 1536, O_MK = 2048, O_MV = 2560;
constexpr int O_Z = 3072;
constexpr int PMW = 3328;
constexpr int PMN = 3328;
constexpr int PJN = 5376;
constexpr int GTW = 2048;
constexpr float EPS = 1e-6f;

__constant__ unsigned char BUCKET[128] = {0, 1, 2, 3, 4, 5, 6, 7, 8, 9, 10, 11, 12, 13, 14, 15, 16, 16, 16, 17, 17, 18, 18, 18, 19, 19, 19, 20, 20, 20, 20, 21, 21, 21, 21, 22, 22, 22, 22, 22, 23, 23, 23, 23, 23, 23, 24, 24, 24, 24, 24, 24, 25, 25, 25, 25, 25, 25, 25, 26, 26, 26, 26, 26, 26, 26, 26, 27, 27, 27, 27, 27, 27, 27, 27, 27, 27, 28, 28, 28, 28, 28, 28, 28, 28, 28, 28, 29, 29, 29, 29, 29, 29, 29, 29, 29, 29, 29, 29, 30, 30, 30, 30, 30, 30, 30, 30, 30, 30, 30, 30, 30, 30, 31, 31, 31, 31, 31, 31, 31, 31, 31, 31, 31, 31, 31, 31, 31};

__device__ __forceinline__ float silu_f(float x) { return x * __builtin_amdgcn_rcpf(1.f + __expf(-x)); }
__device__ __forceinline__ float sigmoid_f(float x) { return __builtin_amdgcn_rcpf(1.f + __expf(-x)); }
__device__ __forceinline__ float logsigmoid_f(float x) { return fminf(x, 0.f) - log1pf(__expf(-fabsf(x))); }
__device__ __forceinline__ float bf2f(unsigned short v) { return __uint_as_float((unsigned)v << 16); }
typedef float f32x2_t __attribute__((ext_vector_type(2))); typedef __bf16 bf16x2_t __attribute__((ext_vector_type(2)));
__device__ __forceinline__ unsigned pk2(float lo, float hi) { f32x2_t v = {lo, hi}; bf16x2_t b = __builtin_convertvector(v, bf16x2_t); return __builtin_bit_cast(unsigned, b); }
__device__ __forceinline__ float lo_bf(unsigned w) { return __uint_as_float(w << 16); }
__device__ __forceinline__ float hi_bf(unsigned w) { return __uint_as_float(w & 0xffff0000u); }

namespace pg8 {
#define PG8_LAS __attribute__((address_space(3)))
typedef unsigned short bf16_t;
typedef short bf16x8 __attribute__((ext_vector_type(8)));
typedef float f32x4 __attribute__((ext_vector_type(4)));
typedef unsigned u32x4 __attribute__((ext_vector_type(4)));
constexpr int BM = 256, BK = 64, HALF = 128, HTB = HALF * BK * 2  , STAGE_BYTES = 8 * HTB, NXCD = 8, WGM = 8;

__host__ __device__ __forceinline__ int lds_byte(int r, int c) { const int st = (r >> 4) * 2 + (c >> 5), rr = r & 15, cc = c & 31, ob = rr * 64 + cc * 2; return st * 1024 + (ob ^ (((ob >> 9) & 1) << 5)); }
__host__ __device__ __forceinline__ void stage_rc(int b, int& R, int& C) { const int st = b / 1024, sb = b % 1024, swz = sb ^ (((sb >> 9) & 1) << 5); R = (st >> 1) * 16 + swz / 64; C = (st & 1) * 32 + (swz % 64) / 2; }
__host__ __device__ __forceinline__ int perm32(int rho) { const int n = rho >> 4, i = rho & 15; return 8 * (i >> 2) + 4 * n + (i & 3); }

struct Unit { int pm, pn; };
struct Gemm { const bf16_t* A; const bf16_t* Bt; int M, N, K; const bf16_t* A2 = nullptr; int lda = 0; int ksw = 0; };

struct StaticOrder {
    int nM, nN, nwg, G, c;
    __host__ __device__ void init(int M, int N, int G_, int c_) { nM = M / BM; nN = N / BM; nwg = nM * nN; G = G_; c = c_; }
    __host__ __device__ bool next(int i, Unit& u) const {
        const long L = (long)i * G + c; if (L >= nwg) return false;
        int wgid = (int)L; { const int q = nwg / NXCD, r = nwg % NXCD, xcd = wgid % NXCD, off = wgid / NXCD; wgid = (xcd < r ? xcd * (q + 1) : r * (q + 1) + (xcd - r) * q) + off; }
        const int nig = WGM * nN, gid = wgid / nig, fm = gid * WGM, gsz = (nM - fm) < WGM ? (nM - fm) : WGM;
        u.pm = fm + ((wgid % nig) % gsz); u.pn = (wgid % nig) / gsz; return true;
    }
    __device__ __forceinline__ void a_ready(const Unit&) const {}
    __device__ __forceinline__ void done(const Unit&) const {}
};


struct EpiSwiGLU {
    static constexpr bool PERM = true, AFTER_DRAIN = false, HAS_MID = false;
    bf16_t* O; int ldc; int pad;
    __device__ __forceinline__ void operator()(const f32x4 (&acc)[2][2][4][2], const Unit& u, int wr, int wc, int fr, int fq) const {
        const int row0 = u.pm * BM + wr * 64 + fr, col0 = u.pn * HALF + wc * 32 + 8 * fq;
#pragma unroll
        for (int ai = 0; ai < 2; ++ai)
#pragma unroll
            for (int m = 0; m < 4; ++m) {
                bf16_t* rowp = O + (size_t)(row0 + ai * HALF + m * 16) * ldc + col0;
                const f32x4 g0 = acc[ai][0][m][0], g1 = acc[ai][0][m][1], u0 = acc[ai][1][m][0], u1 = acc[ai][1][m][1];
                u32x4 w;
                w.x = pk2(silu_f(g0[0]) * u0[0], silu_f(g0[1]) * u0[1]); w.y = pk2(silu_f(g0[2]) * u0[2], silu_f(g0[3]) * u0[3]);
                w.z = pk2(silu_f(g1[0]) * u1[0], silu_f(g1[1]) * u1[1]); w.w = pk2(silu_f(g1[2]) * u1[2], silu_f(g1[3]) * u1[3]);
                *(u32x4*)rowp = w;
            }
    }
};
template <bool BASEBF> struct EpiResid {
    static constexpr bool PERM = true, AFTER_DRAIN = false, HAS_MID = false;
    const void* base; bf16_t* out; const float* gate; float fac;
    __device__ __forceinline__ void operator()(const f32x4 (&acc)[2][2][4][2], const Unit& u, int wr, int wc, int fr, int fq) const {
        const int row0 = u.pm * BM + wr * 64 + fr, col0 = u.pn * BM + wc * 32 + 8 * fq;
        const float* gp = gate + (size_t)(u.pm / (SEQ / BM)) * (NMOD * D) + col0;
#pragma unroll
        for (int bj = 0; bj < 2; ++bj) {
            const f32x4 ga = *(const f32x4*)(gp + bj * HALF) * fac, gb = *(const f32x4*)(gp + bj * HALF + 4) * fac;
#pragma unroll
            for (int ai = 0; ai < 2; ++ai)
#pragma unroll
                for (int m = 0; m < 4; ++m) {
                    const size_t off = (size_t)(row0 + ai * HALF + m * 16) * D + col0 + bj * HALF;
                    f32x4 b0, b1;
                    if (BASEBF) { const u32x4 p = *(const u32x4*)((const bf16_t*)base + off); b0 = (f32x4){lo_bf(p.x), hi_bf(p.x), lo_bf(p.y), hi_bf(p.y)}; b1 = (f32x4){lo_bf(p.z), hi_bf(p.z), lo_bf(p.w), hi_bf(p.w)}; }
                    else { b0 = *(const f32x4*)((const float*)base + off); b1 = *(const f32x4*)((const float*)base + off + 4); }
                    const f32x4 v0 = b0 + ga * acc[ai][bj][m][0], v1 = b1 + gb * acc[ai][bj][m][1];
                    u32x4 w; w.x = pk2(v0[0], v0[1]); w.y = pk2(v0[2], v0[3]); w.z = pk2(v1[0], v1[1]); w.w = pk2(v1[2], v1[3]);
                    *(u32x4*)(out + off) = w;
                    if (BASEBF ? (m == 3 && ai == 1) : (m == 3)) asm volatile("" ::: "memory");
                }
        }
    }
};
template <int ACT> struct EpiBf16 {
    static constexpr bool PERM = true, AFTER_DRAIN = false, HAS_MID = false;
    bf16_t* O; int ldc; int ncols; bf16_t* Z; const float* zb;
    __device__ __forceinline__ void operator()(const f32x4 (&acc)[2][2][4][2], const Unit& u, int wr, int wc, int fr, int fq) const {
        const int row0 = u.pm * BM + wr * 64 + fr, col0 = u.pn * BM + wc * 32 + 8 * fq;
        const bool isz = u.pn * BM >= ncols;
        bf16_t* ob = isz ? Z : O; const int ld = isz ? BM : ldc, cb = isz ? col0 - ncols : col0;
        f32x4 bv[2][2];
#pragma unroll
        for (int bj = 0; bj < 2; ++bj) { bv[bj][0] = isz ? *(const f32x4*)(zb + cb + bj * HALF) : (f32x4){0.f, 0.f, 0.f, 0.f}; bv[bj][1] = isz ? *(const f32x4*)(zb + cb + bj * HALF + 4) : (f32x4){0.f, 0.f, 0.f, 0.f}; }
#pragma unroll
        for (int ai = 0; ai < 2; ++ai)
#pragma unroll
            for (int m = 0; m < 4; ++m) {
                bf16_t* rowp = ob + (size_t)(row0 + ai * HALF + m * 16) * ld + cb;
#pragma unroll
                for (int bj = 0; bj < 2; ++bj) {
                    f32x4 v0 = acc[ai][bj][m][0] + bv[bj][0], v1 = acc[ai][bj][m][1] + bv[bj][1];
                    if (ACT == 1) {
#pragma unroll
                        for (int i = 0; i < 4; ++i) { v0[i] = sigmoid_f(v0[i]); v1[i] = sigmoid_f(v1[i]); }
                    }
                    u32x4 w; w.x = pk2(v0[0], v0[1]); w.y = pk2(v0[2], v0[3]); w.z = pk2(v1[0], v1[1]); w.w = pk2(v1[2], v1[3]);
                    *(u32x4*)(rowp + bj * HALF) = w;
                }
            }
    }
};
struct EpiGateMul {
    static constexpr bool PERM = true, AFTER_DRAIN = false, HAS_MID = false;
    bf16_t* O; const bf16_t* gates; int goff; int add;
    __device__ __forceinline__ void operator()(const f32x4 (&acc)[2][2][4][2], const Unit& u, int wr, int wc, int fr, int fq) const {
        const int row0 = u.pm * BM + wr * 64 + fr, col0 = u.pn * BM + wc * 32 + 8 * fq;
#pragma unroll
        for (int ai = 0; ai < 2; ++ai)
#pragma unroll
            for (int m = 0; m < 4; ++m) {
                const int row = row0 + ai * HALF + m * 16;
#pragma unroll
                for (int bj = 0; bj < 2; ++bj) {
                    const int col = col0 + bj * HALF;
                    const u32x4 g = *(const u32x4*)(gates + (size_t)row * GTW + goff + col);
                    bf16_t* op = O + (size_t)row * D + col;
                    const f32x4 a0 = acc[ai][bj][m][0], a1 = acc[ai][bj][m][1];
                    float t[8] = {lo_bf(g.x) * a0[0], hi_bf(g.x) * a0[1], lo_bf(g.y) * a0[2], hi_bf(g.y) * a0[3], lo_bf(g.z) * a1[0], hi_bf(g.z) * a1[1], lo_bf(g.w) * a1[2], hi_bf(g.w) * a1[3]};
                    if (add) { const u32x4 p = *(const u32x4*)op;
                        t[0] += lo_bf(p.x); t[1] += hi_bf(p.x); t[2] += lo_bf(p.y); t[3] += hi_bf(p.y); t[4] += lo_bf(p.z); t[5] += hi_bf(p.z); t[6] += lo_bf(p.w); t[7] += hi_bf(p.w); }
                    u32x4 w; w.x = pk2(t[0], t[1]); w.y = pk2(t[2], t[3]); w.z = pk2(t[4], t[5]); w.w = pk2(t[6], t[7]);
                    *(u32x4*)op = w;
                }
            }
    }
};
typedef unsigned u32x2 __attribute__((ext_vector_type(2)));
struct EpiProj {
    static constexpr bool PERM = true, AFTER_DRAIN = false, HAS_MID = false;
    bf16_t* O; unsigned char* G8; const float* zb;
    __device__ __forceinline__ void operator()(const f32x4 (&acc)[2][2][4][2], const Unit& u, int wr, int wc, int fr, int fq) const {
        const int row0 = u.pm * BM + wr * 64 + fr, col0 = u.pn * BM + wc * 32 + 8 * fq;
        if (u.pn * BM < PMN) {
            const bool isz = u.pn * BM == O_Z;
            f32x4 bv[2][2];
#pragma unroll
            for (int bj = 0; bj < 2; ++bj) { bv[bj][0] = isz ? *(const f32x4*)(zb + col0 - O_Z + bj * HALF) : (f32x4){0.f, 0.f, 0.f, 0.f}; bv[bj][1] = isz ? *(const f32x4*)(zb + col0 - O_Z + bj * HALF + 4) : (f32x4){0.f, 0.f, 0.f, 0.f}; }
#pragma unroll
            for (int ai = 0; ai < 2; ++ai)
#pragma unroll
                for (int m = 0; m < 4; ++m) {
                    bf16_t* rowp = O + (size_t)(row0 + ai * HALF + m * 16) * PMW + col0;
#pragma unroll
                    for (int bj = 0; bj < 2; ++bj) {
                        const f32x4 v0 = acc[ai][bj][m][0] + bv[bj][0], v1 = acc[ai][bj][m][1] + bv[bj][1];
                        u32x4 w; w.x = pk2(v0[0], v0[1]); w.y = pk2(v0[2], v0[3]); w.z = pk2(v1[0], v1[1]); w.w = pk2(v1[2], v1[3]);
                        *(u32x4*)(rowp + bj * HALF) = w;
                    }
                }
        } else {
#pragma unroll
            for (int ai = 0; ai < 2; ++ai)
#pragma unroll
                for (int m = 0; m < 4; ++m) {
                    unsigned char* rowp = G8 + (size_t)(row0 + ai * HALF + m * 16) * GTW + (col0 - PMN);
#pragma unroll
                    for (int bj = 0; bj < 2; ++bj) {
                        unsigned q8[8];
#pragma unroll
                        for (int i = 0; i < 4; ++i) { q8[i] = (unsigned)fmaxf(1.f, __builtin_rintf(sigmoid_f(acc[ai][bj][m][0][i]) * 255.f)); q8[4 + i] = (unsigned)fmaxf(1.f, __builtin_rintf(sigmoid_f(acc[ai][bj][m][1][i]) * 255.f)); }
                        u32x2 w; w.x = q8[0] | (q8[1] << 8) | (q8[2] << 16) | (q8[3] << 24); w.y = q8[4] | (q8[5] << 8) | (q8[6] << 16) | (q8[7] << 24);
                        *(u32x2*)(rowp + bj * HALF) = w;
                    }
                }
        }
    }
};
struct EpiGateCat {
    static constexpr bool PERM = true, AFTER_DRAIN = false, HAS_MID = true;
    bf16_t* O; const unsigned char* gates;
    __device__ __forceinline__ void mid(f32x4 (&acc)[2][2][4][2], const Unit& u, int wr, int wc, int fr, int fq) const {
        const int row0 = u.pm * BM + wr * 64 + fr, col0 = u.pn * BM + wc * 32 + 8 * fq;
#pragma unroll
        for (int ai = 0; ai < 2; ++ai)
#pragma unroll
            for (int m = 0; m < 4; ++m) {
                const unsigned char* gp = gates + (size_t)(row0 + ai * HALF + m * 16) * GTW + col0;
#pragma unroll
                for (int bj = 0; bj < 2; ++bj) {
                    const u32x2 a = *(const u32x2*)(gp + bj * HALF), b = *(const u32x2*)(gp + D + bj * HALF);
#pragma unroll
                    for (int i = 0; i < 4; ++i) {
                        acc[ai][bj][m][0][i] *= (float)((a.x >> (8 * i)) & 0xffu) * __builtin_amdgcn_rcpf((float)((b.x >> (8 * i)) & 0xffu));
                        acc[ai][bj][m][1][i] *= (float)((a.y >> (8 * i)) & 0xffu) * __builtin_amdgcn_rcpf((float)((b.y >> (8 * i)) & 0xffu)); }
                }
                asm volatile("" ::: "memory");
            }
    }
    __device__ __forceinline__ void operator()(const f32x4 (&acc)[2][2][4][2], const Unit& u, int wr, int wc, int fr, int fq) const {
        const int row0 = u.pm * BM + wr * 64 + fr, col0 = u.pn * BM + wc * 32 + 8 * fq;
#pragma unroll
        for (int ai = 0; ai < 2; ++ai)
#pragma unroll
            for (int m = 0; m < 4; ++m) {
                const int row = row0 + ai * HALF + m * 16;
#pragma unroll
                for (int bj = 0; bj < 2; ++bj) {
                    const int col = col0 + bj * HALF;
                    const u32x2 g = *(const u32x2*)(gates + (size_t)row * GTW + D + col);
                    const f32x4 a0 = acc[ai][bj][m][0], a1 = acc[ai][bj][m][1];
                    float t[8];
#pragma unroll
                    for (int i = 0; i < 4; ++i) { t[i] = a0[i] * ((float)((g.x >> (8 * i)) & 0xffu) * (1.f / 255.f)); t[4 + i] = a1[i] * ((float)((g.y >> (8 * i)) & 0xffu) * (1.f / 255.f)); }
                    u32x4 w; w.x = pk2(t[0], t[1]); w.y = pk2(t[2], t[3]); w.z = pk2(t[4], t[5]); w.w = pk2(t[6], t[7]);
                    *(u32x4*)(O + (size_t)row * D + col) = w;
                }
            }
    }
};

template <class Epi, class Sched, bool ALIGN_EPI = false, bool SP2 = false>
__device__ __forceinline__ void gemm_phase(PG8_LAS unsigned char* lds, const Gemm g, const Sched& S, const Epi& E, int tid) {
    const int wid = __builtin_amdgcn_readfirstlane(tid >> 6), lane = tid & 63, wr = wid >> 2, wc = wid & 3, fr = lane & 15, fq = lane >> 4;
    const int K = g.K, nt = K / BK, lda = g.lda ? g.lda : K, ksw = g.A2 ? g.ksw : (1 << 30);
    unsigned voffA[2], voffB[2];
#pragma unroll
    for (int i = 0; i < 2; ++i) { int R, C; stage_rc(tid * 16 + i * 8192, R, C); const int Rb = Epi::PERM ? ((R & ~31) + perm32(R & 31)) : R;
        voffA[i] = (unsigned)(R * lda + C) * 2u; voffB[i] = (unsigned)(Rb * K + C) * 2u; }
    const size_t kstep = (size_t)(BK * 2);
    const size_t hstep = (size_t)HALF * K * 2;
    const size_t tstep = 2 * hstep;
    const size_t hstepA = (size_t)HALF * lda * 2, tstepA = 2 * hstepA;
    const char* A2s = g.A2 ? (const char*)g.A2 - (size_t)ksw * kstep : (const char*)g.A;
#define PG8_AP(t_) (((t_) < ksw ? cA : cA2) + (size_t)(t_) * kstep)
    const unsigned ldsw = (unsigned)wid * 1024u;
    const int aoff = lds_byte(wr * 64 + fr, fq * 8), boff = lds_byte(wc * 32 + fr, fq * 8);
#define PG8_SA(b, h) (((b) * 2 + (h)) * HTB)
#define PG8_SB(b, h) ((4 + (b) * 2 + (h)) * HTB)
#define PG8_STAGE(bufoff, gbase, voff) do { _Pragma("unroll") for (int _i = 0; _i < 2; ++_i) \
        __builtin_amdgcn_global_load_lds((const unsigned*)((const char*)(gbase) + (voff)[_i]), (PG8_LAS unsigned*)(lds + (bufoff) + ldsw + _i * 8192), 16, 0, 0); } while (0)
#define PG8_LDA(dst, b, h) do { _Pragma("unroll") for (int m = 0; m < 4; ++m) _Pragma("unroll") for (int k = 0; k < 2; ++k) dst[m][k] = *(const PG8_LAS bf16x8*)(lds + PG8_SA(b, h) + aoff + m * 2048 + k * 1024); } while (0)
#define PG8_LDB(dst, b, h) do { _Pragma("unroll") for (int n = 0; n < 2; ++n) _Pragma("unroll") for (int k = 0; k < 2; ++k) dst[n][k] = *(const PG8_LAS bf16x8*)(lds + PG8_SB(b, h) + boff + n * 2048 + k * 1024); } while (0)
#define PG8_MMA(ai, bj, At, Bt) do { __builtin_amdgcn_s_setprio(1); _Pragma("unroll") for (int m = 0; m < 4; ++m) _Pragma("unroll") for (int n = 0; n < 2; ++n) _Pragma("unroll") for (int k = 0; k < 2; ++k) \
        acc[ai][bj][m][n] = __builtin_amdgcn_mfma_f32_16x16x32_bf16(Bt[n][k], At[m][k], acc[ai][bj][m][n], 0, 0, 0); __builtin_amdgcn_s_setprio(0); } while (0)
#define PG8_WAIT_V(n) asm volatile("s_waitcnt vmcnt(" #n ")" ::: "memory")
#define PG8_WAIT_L(n) asm volatile("s_waitcnt lgkmcnt(" #n ")" ::: "memory")
#define PG8_BAR __builtin_amdgcn_s_barrier()
#define PG8_SCHED __builtin_amdgcn_sched_barrier(0)
    Unit cur, nxt; int ui = 0;
    if (!S.next(0, cur)) return;
    f32x4 acc[2][2][4][2];
#pragma unroll
    for (int a = 0; a < 2; ++a)
#pragma unroll
        for (int b = 0; b < 2; ++b)
#pragma unroll
            for (int m = 0; m < 4; ++m)
#pragma unroll
                for (int n = 0; n < 2; ++n) acc[a][b][m][n] = (f32x4){0.f, 0.f, 0.f, 0.f};
    bf16x8 At[4][2], B0[2][2], B1[2][2];
    const char* cA = (const char*)g.A + (size_t)cur.pm * tstepA; const char* cB = (const char*)g.Bt + (size_t)cur.pn * tstep; const char* cA2 = A2s + (size_t)cur.pm * tstepA;
    S.a_ready(cur);
    if constexpr (SP2) {
        PG8_STAGE(PG8_SB(0, 0), cB, voffB); PG8_STAGE(PG8_SB(0, 1), cB + hstep, voffB); PG8_STAGE(PG8_SA(0, 0), cA, voffA); PG8_STAGE(PG8_SA(0, 1), cA + hstepA, voffA);
        if (wr == 1) PG8_BAR;
        PG8_WAIT_V(2); PG8_BAR;
        PG8_STAGE(PG8_SB(1, 0), cB + kstep, voffB); PG8_STAGE(PG8_SA(1, 0), cA + kstep, voffA); PG8_STAGE(PG8_SB(1, 1), cB + hstep + kstep, voffB);
        PG8_WAIT_V(6); PG8_BAR;
    } else {
        PG8_STAGE(PG8_SB(0, 0), cB, voffB); PG8_STAGE(PG8_SA(0, 0), cA, voffA); PG8_STAGE(PG8_SB(0, 1), cB + hstep, voffB); PG8_STAGE(PG8_SA(0, 1), cA + hstepA, voffA);
        if (wr == 1) PG8_BAR;
        PG8_WAIT_V(4); PG8_BAR;
        PG8_STAGE(PG8_SB(1, 0), cB + kstep, voffB); PG8_STAGE(PG8_SA(1, 0), cA + kstep, voffA); PG8_STAGE(PG8_SB(1, 1), cB + hstep + kstep, voffB);
        PG8_WAIT_V(6); PG8_BAR;
    }
    for (;;) {
        const bool has_next = S.next(ui + 1, nxt);
        const char* nA = has_next ? (const char*)g.A + (size_t)nxt.pm * tstepA : cA; const char* nB = has_next ? (const char*)g.Bt + (size_t)nxt.pn * tstep : cB;
        const char* nA2 = has_next ? A2s + (size_t)nxt.pm * tstepA : cA2;
        for (int t = 0; t < nt; t += 2) {
            const bool last = (t == nt - 2);
            if constexpr (Epi::HAS_MID) { if (t == ksw) E.mid(acc, cur, wr, wc, fr, fq); }
            const char* a1 = PG8_AP(t + 1);
            const char* a2 = last ? nA : PG8_AP(t + 2); const char* b2 = last ? nB : cB + (size_t)(t + 2) * kstep;
            const char* a3 = a2 + kstep; const char* b3 = b2 + kstep;
            if (last && has_next) S.a_ready(nxt);
            if constexpr (SP2) {
            PG8_LDB(B0, 0, 0); PG8_LDB(B1, 0, 1); PG8_SCHED; PG8_LDA(At, 0, 0); PG8_STAGE(PG8_SA(1, 1), a1 + hstepA, voffA);
            PG8_WAIT_V(8); PG8_WAIT_L(0); PG8_BAR; PG8_MMA(0, 0, At, B0); PG8_MMA(0, 1, At, B1); PG8_BAR; PG8_SCHED;
            PG8_LDA(At, 0, 1); PG8_STAGE(PG8_SB(0, 0), b2, voffB); PG8_STAGE(PG8_SB(0, 1), b2 + hstep, voffB); PG8_STAGE(PG8_SA(0, 0), a2, voffA);
            PG8_WAIT_V(8); PG8_WAIT_L(0); PG8_BAR; PG8_MMA(1, 0, At, B0); PG8_MMA(1, 1, At, B1); PG8_BAR; PG8_SCHED;
            PG8_LDB(B0, 1, 0); PG8_LDB(B1, 1, 1); PG8_SCHED; PG8_LDA(At, 1, 0); PG8_STAGE(PG8_SA(0, 1), a2 + hstepA, voffA);
            PG8_WAIT_V(8); PG8_WAIT_L(0); PG8_BAR; PG8_MMA(0, 0, At, B0); PG8_MMA(0, 1, At, B1); PG8_BAR; PG8_SCHED;
            PG8_LDA(At, 1, 1); PG8_STAGE(PG8_SB(1, 0), b3, voffB); PG8_STAGE(PG8_SB(1, 1), b3 + hstep, voffB); PG8_STAGE(PG8_SA(1, 0), a3, voffA);
            PG8_WAIT_V(8); PG8_WAIT_L(0); PG8_BAR; PG8_MMA(1, 0, At, B0); PG8_MMA(1, 1, At, B1); PG8_BAR; PG8_SCHED;
            } else {
            PG8_LDB(B0, 0, 0); PG8_SCHED; PG8_LDA(At, 0, 0); PG8_STAGE(PG8_SA(1, 1), a1 + hstepA, voffA);
            PG8_WAIT_L(8); PG8_BAR; PG8_WAIT_L(0); PG8_MMA(0, 0, At, B0); PG8_BAR; PG8_SCHED;
            PG8_LDB(B1, 0, 1); PG8_STAGE(PG8_SB(0, 0), b2, voffB);
            PG8_BAR; PG8_WAIT_L(0); PG8_MMA(0, 1, At, B1); PG8_BAR;
            PG8_LDA(At, 0, 1); PG8_STAGE(PG8_SA(0, 0), a2, voffA);
            PG8_BAR; PG8_WAIT_L(0); PG8_MMA(1, 0, At, B0); PG8_BAR; PG8_SCHED;
            PG8_STAGE(PG8_SB(0, 1), b2 + hstep, voffB);
            PG8_WAIT_V(6); PG8_BAR; PG8_MMA(1, 1, At, B1); PG8_BAR;
            PG8_LDB(B0, 1, 0); PG8_SCHED; PG8_LDA(At, 1, 0); PG8_STAGE(PG8_SA(0, 1), a2 + hstepA, voffA);
            PG8_WAIT_L(8); PG8_BAR; PG8_WAIT_L(0); PG8_MMA(0, 0, At, B0); PG8_BAR; PG8_SCHED;
            PG8_LDB(B1, 1, 1); PG8_STAGE(PG8_SB(1, 0), b3, voffB);
            PG8_BAR; PG8_WAIT_L(0); PG8_MMA(0, 1, At, B1); PG8_BAR;
            PG8_LDA(At, 1, 1); PG8_STAGE(PG8_SA(1, 0), a3, voffA);
            PG8_BAR; PG8_WAIT_L(0); PG8_MMA(1, 0, At, B0); PG8_BAR; PG8_SCHED;
            PG8_STAGE(PG8_SB(1, 1), b3 + hstep, voffB);
            PG8_WAIT_V(6); PG8_BAR; PG8_MMA(1, 1, At, B1); PG8_BAR;
            }
        }
        if constexpr (ALIGN_EPI) { if (wr == 0) PG8_BAR; }
        if constexpr (!Epi::AFTER_DRAIN) { E(acc, cur, wr, wc, fr, fq); S.done(cur); }
        if (!has_next) break;
#pragma unroll
        for (int a = 0; a < 2; ++a)
#pragma unroll
            for (int b = 0; b < 2; ++b)
#pragma unroll
                for (int m = 0; m < 4; ++m)
#pragma unroll
                    for (int n = 0; n < 2; ++n) acc[a][b][m][n] = (f32x4){0.f, 0.f, 0.f, 0.f};
        cur = nxt; cA = nA; cB = nB; cA2 = nA2; ++ui;
        if constexpr (ALIGN_EPI) { if (wr == 1) PG8_BAR; }
    }
    PG8_WAIT_V(0);
    if constexpr (!ALIGN_EPI) { if (wr == 0) PG8_BAR; }
    PG8_BAR;
    if constexpr (Epi::AFTER_DRAIN) { E.fused(acc, cur, wr, wc, fr, fq, lds, wid, lane); S.done(cur); }
#undef PG8_SA
#undef PG8_AP
#undef PG8_SB
#undef PG8_STAGE
#undef PG8_LDA
#undef PG8_LDB
#undef PG8_MMA
#undef PG8_WAIT_V
#undef PG8_WAIT_L
#undef PG8_BAR
#undef PG8_SCHED
}
}

constexpr size_t MiB = 1u << 20;
constexpr size_t WS_CTL = 0, CTL_ZERO_BYTES = 1 * MiB;
constexpr size_t WS_MOD = 1 * MiB;
constexpr size_t WS_KMEAN = 1 * MiB + 512 * 1024;
constexpr size_t WS_W = 4 * MiB;
constexpr size_t WS_W1GU = WS_W, WS_W1D = WS_W + 11 * MiB, WS_WIN = WS_W + 17 * MiB, WS_WBRA = WS_W + 28 * MiB, WS_WBRB = WS_W + 29 * MiB, WS_WOUT = WS_W + 30 * MiB,
                 WS_W2GU = WS_W + 32 * MiB, WS_W2D = WS_W + 43 * MiB;
constexpr size_t WS_LIST = 53 * MiB, WS_ML = 57 * MiB;
constexpr size_t WS_U = 60 * MiB;
constexpr size_t WS_BIG = 124 * MiB;
constexpr size_t WS_VTG = WS_U;
constexpr size_t WS_PART = 332 * MiB;
constexpr size_t WS_S = 428 * MiB;
constexpr size_t WS_OA = 460 * MiB;
constexpr size_t WS_END = 512 * MiB;
constexpr int CW_BAR = 4096;
constexpr int CW_MCNT = 65536;

constexpr int RING_OFF = 0;
constexpr int LDS_BYTES = 163840;
constexpr int LDSCTL_OFF = LDS_BYTES - 512, MISC_OFF = LDSCTL_OFF + 320;
constexpr int NWAVES = 8;

#define GAS __attribute__((address_space(1)))
#define LAS __attribute__((address_space(3)))
typedef unsigned short bf16;
typedef unsigned v4u __attribute__((ext_vector_type(4)));
typedef unsigned v2u __attribute__((ext_vector_type(2)));
typedef float f32x4 __attribute__((ext_vector_type(4)));
typedef short bf16x8 __attribute__((ext_vector_type(8)));
typedef GAS unsigned gu32;
#define RLX_AGENT __ATOMIC_RELAXED, __HIP_MEMORY_SCOPE_AGENT
#define LDS_WAIT() asm volatile("s_waitcnt lgkmcnt(0)" ::: "memory")
#define VM_WAIT() asm volatile("s_waitcnt vmcnt(0)" ::: "memory")


struct Args { const float* in[22]; float* out; unsigned char* ws; int ph_mask, li, pad0, pad1; };
enum { I_X = 0, I_C, I_WADA, I_BADA, I_NFF1, I_W1G, I_W1U, I_W1D, I_NMIX, I_WIN, I_WLR, I_BLR, I_GNORM, I_RELB, I_WBRA, I_WBRB, I_WOUT, I_NFF2, I_W2G, I_W2U, I_W2D, I_NFIN };

__device__ __forceinline__ float wave_sum(float v) {
#pragma unroll
    for (int o = 1; o < 64; o <<= 1) v += __shfl_xor(v, o);
    return v;
}

#define XB_TMO      128
#define XB_XCNT(j)  (256  + 64 * (j))
#define XB_XSUB(j)  (1280 + 64 * (j))
#define XB_XGEN(j)  (2304 + 64 * (j))
#define XB_TOP      3328
#define XB_TOPGEN   3392
#define XCD_BAR_WORDS 3456
#define XB_SPIN_CAP (1u << 18)

__device__ __forceinline__ unsigned xb_ld(unsigned* p)              { return __hip_atomic_load(p, __ATOMIC_RELAXED, __HIP_MEMORY_SCOPE_AGENT); }
__device__ __forceinline__ unsigned xb_add(unsigned* p, unsigned v) { return __hip_atomic_fetch_add(p, v, __ATOMIC_RELAXED, __HIP_MEMORY_SCOPE_AGENT); }
__device__ __forceinline__ unsigned xb_xcc_id() { return (unsigned)__builtin_amdgcn_s_getreg((3 << 11) | 20) & 0xFu; }
#define XB_SPIN(cond, bar) do { unsigned _sp = 0; while (cond) { __builtin_amdgcn_s_sleep(1); \
    if ((++_sp & 255u) == 0u) { if (xb_ld(&(bar)[XB_TMO])) break; if (_sp > XB_SPIN_CAP) { atomicAdd(&(bar)[XB_TMO], 1u); break; } } } } while (0)

struct XcdBarrier {
    unsigned* bar; unsigned x;
    volatile LAS unsigned* st;
};

__device__ __forceinline__ XcdBarrier xcd_barrier_post(unsigned* bar, volatile LAS unsigned* st) {
    XcdBarrier b; b.bar = bar; b.x = xb_xcc_id(); b.st = st;
    if (threadIdx.x == 0) (void)xb_add(&bar[XB_XCNT(b.x)], 1u);
    return b;
}
__device__ __forceinline__ void xcd_barrier_complete(unsigned* bar, unsigned x, unsigned& nloc, unsigned& nx) {
    const unsigned G = gridDim.x * gridDim.y * gridDim.z;
    unsigned sum, cnt, mine, sp = 0u;
    for (;;) {
        sum = 0u; cnt = 0u; mine = 0u;
#pragma unroll
        for (unsigned j = 0; j < 16; ++j) { const unsigned c = xb_ld(&bar[XB_XCNT(j)]); sum += c; cnt += (c > 0u) ? 1u : 0u; mine = (j == x) ? c : mine; }
        if (sum == G) break;
        __builtin_amdgcn_s_sleep(1);
        if ((++sp & 255u) == 0u) { if (xb_ld(&bar[XB_TMO])) break; if (sp > XB_SPIN_CAP) { atomicAdd(&bar[XB_TMO], 1u); break; } }
    }
    nloc = mine > 0u ? mine : 1u; nx = cnt > 0u ? cnt : 1u;
}

__device__ __forceinline__ void xcd_barrier(const XcdBarrier& b) {
    asm volatile("s_waitcnt vmcnt(0)" ::: "memory");
    __syncthreads();
    if (threadIdx.x == 0) {
        unsigned* bar = b.bar;
        __builtin_amdgcn_s_waitcnt(0);
        unsigned nloc = b.st[0], nx = b.st[1];
        if (nloc == 0u) { xcd_barrier_complete(bar, b.x, nloc, nx); b.st[0] = nloc; b.st[1] = nx; }
        const unsigned old = xb_add(&bar[XB_XSUB(b.x)], 1u);
        const unsigned gen = old / nloc;
        if (old + 1u == (gen + 1u) * nloc) {
            __builtin_amdgcn_fence(__ATOMIC_RELEASE, "agent");
            asm volatile("s_waitcnt vmcnt(0)" ::: "memory");
            const unsigned og = xb_add(&bar[XB_TOP], 1u);
            const unsigned tg = og / nx;
            if (og + 1u == (tg + 1u) * nx) xb_add(&bar[XB_TOPGEN], 1u);
            else XB_SPIN(xb_ld(&bar[XB_TOPGEN]) == tg, bar);
            __builtin_amdgcn_fence(__ATOMIC_ACQUIRE, "agent");
            xb_add(&bar[XB_XGEN(b.x)], 1u);
            asm volatile("s_waitcnt vmcnt(0)" ::: "memory");
        } else {
            XB_SPIN(xb_ld(&bar[XB_XGEN(b.x)]) == gen, bar);
            __builtin_amdgcn_fence(__ATOMIC_ACQUIRE, "agent");
            asm volatile("s_waitcnt vmcnt(0)" ::: "memory");
        }
    }
    __syncthreads();
}

constexpr size_t WS_DEC = 2 * MiB;
constexpr int GLA_UNITS = BATCH * GH * (SEQ / 64);
constexpr int GL_QT = 0, GL_KK = 9216, GL_VT = 18432, GL_PP = 36864, GL_OF = 46080, GL_WS = 79872, GL_RAW = 81920;
typedef float f32x4_t __attribute__((ext_vector_type(4)));
__device__ __forceinline__ f32x4 mfma16(bf16x8 a, bf16x8 b, f32x4 c) { return __builtin_amdgcn_mfma_f32_16x16x32_bf16(a, b, c, 0, 0, 0); }
__device__ __forceinline__ float logsig_fast(float x) { return fminf(x, 0.f) - __logf(1.f + __expf(-fabsf(x))); }

struct GlaIn {
    v4u zr, qr, kr;
    v4u vv[2];
    v4u gg[2];
    bf16x8 sf[2];
};
template <bool OUT>
__device__ __forceinline__ void gla_load(const Args& a, int unit, int tid, int lane, int wave, GlaIn& in) {
    const int bh = unit >> 7, c = unit & 127, b = bh >> 2, h = bh & 3;
    const bf16* P0 = (const bf16*)(a.ws + WS_BIG) + (size_t)(b * SEQ + c * 64) * PMW;
    { const bf16* zb = P0 + O_Z + h * GDK;
      const int t = 8 * wave + (lane >> 3), d8 = 8 * (lane & 7);
      in.zr = *(const v4u*)(zb + (size_t)t * PMW + d8);
      in.kr = *(const v4u*)(P0 + (size_t)t * PMW + O_GK + h * GDK + d8);
      in.qr = OUT ? *(const v4u*)(P0 + (size_t)t * PMW + O_GQ + h * GDK + d8) : (v4u){0u, 0u, 0u, 0u}; }
#pragma unroll
    for (int rep = 0; rep < 2; ++rep) in.vv[rep] = *(const v4u*)(P0 + (size_t)(2 * (tid & 31) + rep) * PMW + O_GV + h * GDV + (tid >> 5) * 8);
    if (OUT) {
        const int t = tid >> 3, g = tid & 7;
#pragma unroll
        for (int hh = 0; hh < 2; ++hh) in.gg[hh] = *(const v4u*)(P0 + (size_t)t * PMW + O_GOG + h * GDV + 64 * hh + 8 * g);
        const bf16* ST = (const bf16*)(a.ws + WS_S) + ((size_t)unit * GDV + 16 * wave + (lane & 15)) * GDK + 8 * (lane >> 4);
        in.sf[0] = *(const bf16x8*)ST; in.sf[1] = *(const bf16x8*)(ST + 32);
    }
}
template <bool OUT>
__device__ __forceinline__ void gla_unpack(const GlaIn& in, LAS unsigned char* lds, int wave, int lane, unsigned (&z)[8], unsigned (&qk)[8]) {
    LAS unsigned char* slab = lds + GL_RAW + wave * 3072;
    const int wo = (lane >> 3) * 128 + (lane & 7) * 16;
    *(LAS v4u*)(slab + wo) = in.zr; *(LAS v4u*)(slab + 1024 + wo) = in.kr; if (OUT) *(LAS v4u*)(slab + 2048 + wo) = in.qr;
    const LAS bf16* s16 = (const LAS bf16*)slab + lane;
#pragma unroll
    for (int i = 0; i < 8; ++i) { z[i] = s16[i * 64]; qk[i] = (OUT ? (unsigned)s16[1024 + i * 64] : 0u) << 0; qk[i] = (OUT ? (unsigned)s16[1024 + i * 64] : 0u) | ((unsigned)s16[512 + i * 64] << 16); }
    asm volatile("s_waitcnt lgkmcnt(0)" ::: "memory");
}
__device__ __forceinline__ void gla_gates(const unsigned (&z)[8], int wave, int lane, LAS float* wsum, float (&bc)[8], float& blast) {
    float run = 0.f;
#pragma unroll
    for (int i = 0; i < 8; ++i) {
        run += logsig_fast(lo_bf(z[i])) * (1.f / 16.f);
        bc[i] = run;
    }
    wsum[wave * 64 + lane] = run;
    __syncthreads();
    float off = 0.f, tot = 0.f;
#pragma unroll
    for (int w = 0; w < NWAVES; ++w) { const float v = wsum[w * 64 + lane]; tot += v; off += (w < wave) ? v : 0.f; }
#pragma unroll
    for (int i = 0; i < 8; ++i) bc[i] += off;
    blast = tot;
}
__device__ __forceinline__ void gla_stage_vt(const GlaIn& in, LAS bf16* VT, int tid) {
    LAS unsigned* dst = (LAS unsigned*)VT + ((tid >> 5) * 8) * 36 + (tid & 31);
    const v4u a = in.vv[0], b = in.vv[1];
    dst[0 * 36] = (a.x & 0xffffu) | (b.x << 16); dst[1 * 36] = (a.x >> 16) | (b.x & 0xffff0000u);
    dst[2 * 36] = (a.y & 0xffffu) | (b.y << 16); dst[3 * 36] = (a.y >> 16) | (b.y & 0xffff0000u);
    dst[4 * 36] = (a.z & 0xffffu) | (b.z << 16); dst[5 * 36] = (a.z >> 16) | (b.z & 0xffff0000u);
    dst[6 * 36] = (a.w & 0xffffu) | (b.w << 16); dst[7 * 36] = (a.w >> 16) | (b.w & 0xffff0000u);
}

__device__ __forceinline__ void gla_local_unit(const Args& a, LAS unsigned char* lds, int unit, const GlaIn& in, int tid, int lane, int wave) {
    LAS bf16* KT = (LAS bf16*)(lds + GL_QT); LAS bf16* VT = (LAS bf16*)(lds + GL_VT); LAS float* wsum = (LAS float*)(lds + GL_WS);
    unsigned z[8], qk[8]; gla_unpack<false>(in, lds, wave, lane, z, qk);
    float bc[8], blast;
    gla_gates(z, wave, lane, wsum, bc, blast);
    float kt[8];
#pragma unroll
    for (int i = 0; i < 8; ++i) kt[i] = hi_bf(qk[i]) * __expf(blast - bc[i]);
    { v4u w; w.x = pk2(kt[0], kt[1]); w.y = pk2(kt[2], kt[3]); w.z = pk2(kt[4], kt[5]); w.w = pk2(kt[6], kt[7]); *(LAS v4u*)(KT + lane * 72 + 8 * wave) = w; }
    gla_stage_vt(in, VT, tid);
    if (wave == 0) ((float*)(a.ws + WS_DEC))[(size_t)unit * 64 + lane] = __expf(blast);
    __syncthreads();
    f32x4 acc[4];
#pragma unroll
    for (int dt = 0; dt < 4; ++dt) acc[dt] = (f32x4){0.f, 0.f, 0.f, 0.f};
#pragma unroll
    for (int ks = 0; ks < 2; ++ks) {
        const bf16x8 bfr = *(const LAS bf16x8*)(VT + (16 * wave + (lane & 15)) * 72 + 32 * ks + 8 * (lane >> 4));
#pragma unroll
        for (int dt = 0; dt < 4; ++dt) { const bf16x8 afr = *(const LAS bf16x8*)(KT + (16 * dt + (lane & 15)) * 72 + 32 * ks + 8 * (lane >> 4)); acc[dt] = mfma16(afr, bfr, acc[dt]); }
    }
    bf16* ST = (bf16*)(a.ws + WS_S) + ((size_t)unit * GDV + 16 * wave + (lane & 15)) * GDK + 4 * (lane >> 4);
#pragma unroll
    for (int dt = 0; dt < 4; ++dt) { v2u o; o.x = pk2(acc[dt][0], acc[dt][1]); o.y = pk2(acc[dt][2], acc[dt][3]); *(v2u*)(ST + 16 * dt) = o; }
    __syncthreads();
}
__device__ __forceinline__ void gla_local_phase(const Args& a, LAS unsigned char* lds, int tid, int lane, int wave, int vcu, int G) {
    if (vcu >= GLA_UNITS) return;
    GlaIn A, B; gla_load<false>(a, vcu, tid, lane, wave, A);
    for (int u = vcu;;) {
        if (u + G < GLA_UNITS) gla_load<false>(a, u + G, tid, lane, wave, B);
        gla_local_unit(a, lds, u, A, tid, lane, wave);
        u += G; if (u >= GLA_UNITS) break;
        if (u + G < GLA_UNITS) gla_load<false>(a, u + G, tid, lane, wave, A);
        gla_local_unit(a, lds, u, B, tid, lane, wave);
        u += G; if (u >= GLA_UNITS) break;
    }
}

__device__ __forceinline__ void gla_scan(const Args& a, int gthread) {
    const int dp = gthread & 31, e = (gthread >> 5) & 127, bh = gthread >> 12;
    unsigned* st = (unsigned*)(a.ws + WS_S) + ((size_t)(bh * 128) * GDV + e) * (GDK / 2) + dp;
    const f32x2_t* dec = (const f32x2_t*)(a.ws + WS_DEC) + (size_t)(bh * 128) * (GDK / 2) + dp;
    float s0 = 0.f, s1 = 0.f;
#pragma unroll 32
    for (int c = 0; c < 128; ++c) {
        const unsigned L = st[(size_t)c * (GDV * GDK / 2)]; const f32x2_t d2 = dec[(size_t)c * (GDK / 2)];
        st[(size_t)c * (GDV * GDK / 2)] = pk2(s0, s1);
        s0 = d2.x * s0 + lo_bf(L); s1 = d2.y * s1 + hi_bf(L);
    }
}

__device__ __forceinline__ void gla_out_unit(const Args& a, LAS unsigned char* lds, int unit, const GlaIn& in, const f32x4 (&gnv)[4], int tid, int lane, int wave) {
    const int bh = unit >> 7, c = unit & 127, b = bh >> 2, h = bh & 3;
    const size_t row0 = (size_t)(b * SEQ + c * 64);
    LAS bf16* QT = (LAS bf16*)(lds + GL_QT); LAS bf16* KK = (LAS bf16*)(lds + GL_KK); LAS bf16* VT = (LAS bf16*)(lds + GL_VT); LAS bf16* PP = (LAS bf16*)(lds + GL_PP);
    LAS float* OF = (LAS float*)(lds + GL_OF); LAS float* wsum = (LAS float*)(lds + GL_WS);
    unsigned z[8], qk[8]; gla_unpack<true>(in, lds, wave, lane, z, qk);
    float bc[8], blast;
    gla_gates(z, wave, lane, wsum, bc, blast);
#pragma unroll
    for (int i = 0; i < 8; ++i) {
        const int t = 8 * wave + i;
        const float q = lo_bf(qk[i]) * 0.125f * __expf(bc[i]);
        const float k = hi_bf(qk[i]) * __expf(-bc[i]);
        QT[t * 72 + lane] = (bf16)(pk2(q, 0.f) & 0xffff); KK[t * 72 + lane] = (bf16)(pk2(k, 0.f) & 0xffff);
    }
    gla_stage_vt(in, VT, tid);
    __syncthreads();
    const int fr = lane & 15, fq = lane >> 4;
    {
        const int tt = wave >> 1;
        f32x4 p[2] = {(f32x4){0.f, 0.f, 0.f, 0.f}, (f32x4){0.f, 0.f, 0.f, 0.f}};
#pragma unroll
        for (int ks = 0; ks < 2; ++ks) {
            const bf16x8 afr = *(const LAS bf16x8*)(QT + (16 * tt + fr) * 72 + 32 * ks + 8 * fq);
#pragma unroll
            for (int jj = 0; jj < 2; ++jj) { const int jt = 2 * (wave & 1) + jj; const bf16x8 bfr = *(const LAS bf16x8*)(KK + (16 * jt + fr) * 72 + 32 * ks + 8 * fq); p[jj] = mfma16(afr, bfr, p[jj]); }
        }
#pragma unroll
        for (int jj = 0; jj < 2; ++jj) { const int j = 16 * (2 * (wave & 1) + jj) + fr;
#pragma unroll
            for (int r = 0; r < 4; ++r) { const int t = 16 * tt + 4 * fq + r; PP[t * 72 + j] = (bf16)(pk2(j <= t ? p[jj][r] : 0.f, 0.f) & 0xffff); } }
    }
    f32x4 o[4];
#pragma unroll
    for (int tt = 0; tt < 4; ++tt) o[tt] = (f32x4){0.f, 0.f, 0.f, 0.f};
#pragma unroll
    for (int ks = 0; ks < 2; ++ks) {
#pragma unroll
        for (int tt = 0; tt < 4; ++tt) { const bf16x8 afr = *(const LAS bf16x8*)(QT + (16 * tt + fr) * 72 + 32 * ks + 8 * fq); o[tt] = mfma16(afr, in.sf[ks], o[tt]); }
    }
    __syncthreads();
#pragma unroll
    for (int ks = 0; ks < 2; ++ks) {
        const bf16x8 bfr = *(const LAS bf16x8*)(VT + (16 * wave + fr) * 72 + 32 * ks + 8 * fq);
#pragma unroll
        for (int tt = 0; tt < 4; ++tt) { const bf16x8 afr = *(const LAS bf16x8*)(PP + (16 * tt + fr) * 72 + 32 * ks + 8 * fq); o[tt] = mfma16(afr, bfr, o[tt]); }
    }
#pragma unroll
    for (int tt = 0; tt < 4; ++tt)
#pragma unroll
        for (int r = 0; r < 4; ++r) OF[(16 * tt + 4 * fq + r) * 132 + 16 * wave + fr] = o[tt][r];
    __syncthreads();
    {
        const int t = tid >> 3, g = tid & 7;
        f32x4 v[4]; float s = 0.f;
#pragma unroll
        for (int i = 0; i < 4; ++i) { v[i] = *(const LAS f32x4*)(OF + t * 132 + 64 * (i >> 1) + 8 * g + 4 * (i & 1)); s += (v[i].x * v[i].x + v[i].y * v[i].y) + (v[i].z * v[i].z + v[i].w * v[i].w); }
        s += __shfl_xor(s, 1); s += __shfl_xor(s, 2); s += __shfl_xor(s, 4);
        const float rstd = rsqrtf(s * (1.f / GDV) + EPS);
        bf16* op = (bf16*)(a.ws + WS_OA) + (row0 + t) * (GH * GDV) + h * GDV;
#pragma unroll
        for (int hh = 0; hh < 2; ++hh) {
            const int e0 = 64 * hh + 8 * g;
            const v4u gg = in.gg[hh];
            const f32x4 x0 = v[2 * hh] * rstd * gnv[2 * hh], x1 = v[2 * hh + 1] * rstd * gnv[2 * hh + 1];
            v4u w; w.x = pk2(x0.x * silu_f(lo_bf(gg.x)), x0.y * silu_f(hi_bf(gg.x))); w.y = pk2(x0.z * silu_f(lo_bf(gg.y)), x0.w * silu_f(hi_bf(gg.y)));
            w.z = pk2(x1.x * silu_f(lo_bf(gg.z)), x1.y * silu_f(hi_bf(gg.z))); w.w = pk2(x1.z * silu_f(lo_bf(gg.w)), x1.w * silu_f(hi_bf(gg.w)));
            *(v4u*)(op + e0) = w;
        }
    }
    __syncthreads();
}
__device__ __forceinline__ void gla_out_phase(const Args& a, LAS unsigned char* lds, int tid, int lane, int wave, int vcu, int G) {
    if (vcu >= GLA_UNITS) return;
    f32x4 gnv[4];
    { const int g = tid & 7;
#pragma unroll
      for (int hh = 0; hh < 2; ++hh) { gnv[2 * hh] = *(const f32x4*)(a.in[I_GNORM] + 64 * hh + 8 * g); gnv[2 * hh + 1] = *(const f32x4*)(a.in[I_GNORM] + 64 * hh + 8 * g + 4); } }
    GlaIn A, B; gla_load<true>(a, vcu, tid, lane, wave, A);
    for (int u = vcu;;) {
        if (u + G < GLA_UNITS) gla_load<true>(a, u + G, tid, lane, wave, B);
        gla_out_unit(a, lds, u, A, gnv, tid, lane, wave);
        u += G; if (u >= GLA_UNITS) break;
        if (u + G < GLA_UNITS) gla_load<true>(a, u + G, tid, lane, wave, A);
        gla_out_unit(a, lds, u, B, gnv, tid, lane, wave);
        u += G; if (u >= GLA_UNITS) break;
    }
}

typedef float f32x16 __attribute__((ext_vector_type(16)));
__device__ __forceinline__ f32x16 mfma32(bf16x8 a, bf16x8 b, f32x16 c) { return __builtin_amdgcn_mfma_f32_32x32x16_bf16(a, b, c, 0, 0, 0); }
constexpr float LOG2E = 1.4426950408889634f;
constexpr float QK_C1 = 0.08838834764831845f * 1.4426950408889634f;
constexpr int AT_KS = 0, AT_VT = 65536, AT_TAB = 131072, AT_CNT = 132096, AT_PRE = 134144;
constexpr int LIST_PER_BH = 256 * 496;
__host__ __device__ __forceinline__ int list_off(int n) { return 256 * (31 * n - (n * (n - 1)) / 2); }

__device__ __forceinline__ void moba_prep_unit(const Args& a, LAS unsigned char* lds, int u, int tid) {
    const int bh = u >> 5, n = u & 31, b = bh >> 2, h = bh & 3;
    const bf16* base = (const bf16*)(a.ws + WS_BIG) + (size_t)(b * SEQ + n * MBLK) * PMW + O_MK + h * MDH;
    const int jg = tid >> 4, d0 = (tid & 15) * 8;
    float acc[8];
#pragma unroll
    for (int i = 0; i < 8; ++i) acc[i] = 0.f;
#pragma unroll
    for (int i = 0; i < 8; ++i) { const v4u v = *(const v4u*)(base + (size_t)(jg + 32 * i) * PMW + d0);
        acc[0] += lo_bf(v.x); acc[1] += hi_bf(v.x); acc[2] += lo_bf(v.y); acc[3] += hi_bf(v.y); acc[4] += lo_bf(v.z); acc[5] += hi_bf(v.z); acc[6] += lo_bf(v.w); acc[7] += hi_bf(v.w); }
    LAS float* red = (LAS float*)lds;
    *(LAS f32x4*)(red + jg * 128 + d0) = (f32x4){acc[0], acc[1], acc[2], acc[3]}; *(LAS f32x4*)(red + jg * 128 + d0 + 4) = (f32x4){acc[4], acc[5], acc[6], acc[7]};
    __syncthreads();
    if (tid < 128) { float s = 0.f;
#pragma unroll 8
        for (int j = 0; j < 32; ++j) s += red[j * 128 + tid];
        ((float*)(a.ws + WS_KMEAN))[(size_t)u * MDH + tid] = s * (1.f / MBLK); }
    __syncthreads();
    {
        const bf16* vb = (const bf16*)(a.ws + WS_BIG) + (size_t)(b * SEQ + n * MBLK) * PMW + O_MV + h * MDH;
        LAS unsigned* T = (LAS unsigned*)lds;
#pragma unroll
        for (int i = 0; i < 4; ++i) {
            const int p = (tid & 31) + 32 * i, chn = tid >> 5;
            const v4u x = *(const v4u*)(vb + (size_t)(2 * p) * PMW + 8 * chn), y = *(const v4u*)(vb + (size_t)(2 * p + 1) * PMW + 8 * chn);
            LAS unsigned* dst = T + (8 * chn) * 132 + p;
            dst[0 * 132] = (x.x & 0xffffu) | (y.x << 16); dst[1 * 132] = (x.x >> 16) | (y.x & 0xffff0000u);
            dst[2 * 132] = (x.y & 0xffffu) | (y.y << 16); dst[3 * 132] = (x.y >> 16) | (y.y & 0xffff0000u);
            dst[4 * 132] = (x.z & 0xffffu) | (y.z << 16); dst[5 * 132] = (x.z >> 16) | (y.z & 0xffff0000u);
            dst[6 * 132] = (x.w & 0xffffu) | (y.w << 16); dst[7 * 132] = (x.w >> 16) | (y.w & 0xffff0000u);
        }
        __syncthreads();
        bf16* vt = (bf16*)(a.ws + WS_VTG) + (size_t)u * (MDH * MBLK);
#pragma unroll
        for (int i = 0; i < 8; ++i) { const int idx = tid + 512 * i, d = idx >> 5, oc = idx & 31, j = oc >> 1, hf = oc & 1;
            const v2u lo = *(const LAS v2u*)(T + d * 132 + 8 * j + 2 * hf), hi2 = *(const LAS v2u*)(T + d * 132 + 8 * j + 4 + 2 * hf);
            *(v4u*)(vt + (size_t)d * MBLK + 8 * oc) = (v4u){lo.x, lo.y, hi2.x, hi2.y}; }
        __syncthreads();
    }
}

__device__ __forceinline__ bool topk_better(float va, int ia, float vb, int ib) { return va > vb || (va == vb && ia < ib); }
#define TOPK_INSERT(g_, n_) do { const float tg_ = (g_); const int tn_ = (n_); \
    if (topk_better(tg_, tn_, v0, i0)) { v2 = v1; i2 = i1; v1 = v0; i1 = i0; v0 = tg_; i0 = tn_; } \
    else if (topk_better(tg_, tn_, v1, i1)) { v2 = v1; i2 = i1; v1 = tg_; i1 = tn_; } \
    else if (topk_better(tg_, tn_, v2, i2)) { v2 = tg_; i2 = tn_; } } while (0)
__device__ __forceinline__ void moba_topk_unit(const Args& a, LAS unsigned char* lds, int u, int tid) {
    const int bh = u / 31, cur = 1 + u % 31, b = bh >> 2, h = bh & 3;
    const int lane = tid & 63, wave = tid >> 6, q = lane & 31, hi = lane >> 5;
    LAS float* KM = (LAS float*)lds;
    LAS unsigned* hist = (LAS unsigned*)(lds + 17408);
    const float* kmg = (const float*)(a.ws + WS_KMEAN) + (size_t)(bh * NBLK) * MDH;
    for (int i = tid; i < 32 * MDH; i += NWAVES * 64) { const int n = i >> 7; KM[n * 132 + (i & 127)] = n < cur ? kmg[i] : 0.f; }
    if (tid < 64) hist[tid] = 0u;
    float qv[64];
    { const bf16* qp = (const bf16*)(a.ws + WS_BIG) + (size_t)(b * SEQ + cur * MBLK + 32 * wave + q) * PMW + O_MQ + h * MDH + 64 * hi;
#pragma unroll
      for (int i = 0; i < 8; ++i) { const v4u v = *(const v4u*)(qp + 8 * i);
          qv[8 * i + 0] = lo_bf(v.x); qv[8 * i + 1] = hi_bf(v.x); qv[8 * i + 2] = lo_bf(v.y); qv[8 * i + 3] = hi_bf(v.y); qv[8 * i + 4] = lo_bf(v.z); qv[8 * i + 5] = hi_bf(v.z); qv[8 * i + 6] = lo_bf(v.w); qv[8 * i + 7] = hi_bf(v.w); } }
    __syncthreads();
    f32x16 g;
#pragma unroll
    for (int r = 0; r < 16; ++r) g[r] = 0.f;
    { const LAS f32x4* km = (const LAS f32x4*)(KM + q * 132 + 64 * hi);
#pragma unroll
      for (int s4 = 0; s4 < 16; ++s4) { const f32x4 k4 = km[s4];
          g = __builtin_amdgcn_mfma_f32_32x32x2f32(k4.x, qv[4 * s4 + 0], g, 0, 0, 0); g = __builtin_amdgcn_mfma_f32_32x32x2f32(k4.y, qv[4 * s4 + 1], g, 0, 0, 0);
          g = __builtin_amdgcn_mfma_f32_32x32x2f32(k4.z, qv[4 * s4 + 2], g, 0, 0, 0); g = __builtin_amdgcn_mfma_f32_32x32x2f32(k4.w, qv[4 * s4 + 3], g, 0, 0, 0); } }
    float v0 = -INFINITY, v1 = -INFINITY, v2 = -INFINITY; int i0 = 64, i1 = 64, i2 = 64;
#pragma unroll
    for (int r = 0; r < 16; ++r) { const int n = (r & 3) + 8 * (r >> 2) + 4 * hi; const float gv = n < cur ? g[r] : -INFINITY; if (n < cur) TOPK_INSERT(gv, n); }
    { const float w0 = __shfl_xor(v0, 32), w1 = __shfl_xor(v1, 32), w2 = __shfl_xor(v2, 32); const int j0 = __shfl_xor(i0, 32), j1 = __shfl_xor(i1, 32), j2 = __shfl_xor(i2, 32);
      if (j0 < 64) TOPK_INSERT(w0, j0);
      if (j1 < 64) TOPK_INSERT(w1, j1);
      if (j2 < 64) TOPK_INSERT(w2, j2); }
    unsigned p0 = 0, p1 = 0, p2 = 0;
    const int nsel = cur < MTOPK ? cur : MTOPK;
    if (hi == 0) {
        p0 = __hip_atomic_fetch_add(&hist[i0], 1u, __ATOMIC_RELAXED, __HIP_MEMORY_SCOPE_WORKGROUP);
        if (nsel > 1) p1 = __hip_atomic_fetch_add(&hist[i1], 1u, __ATOMIC_RELAXED, __HIP_MEMORY_SCOPE_WORKGROUP);
        if (nsel > 2) p2 = __hip_atomic_fetch_add(&hist[i2], 1u, __ATOMIC_RELAXED, __HIP_MEMORY_SCOPE_WORKGROUP);
    }
    __syncthreads();
    if (tid < cur) hist[32 + tid] = atomicAdd((unsigned*)(a.ws + WS_CTL) + CW_MCNT + bh * NBLK + tid, hist[tid]);
    __syncthreads();
    if (hi == 0) {
        unsigned short* list = (unsigned short*)(a.ws + WS_LIST) + (size_t)bh * LIST_PER_BH;
        const unsigned qs = (unsigned)(cur * MBLK + 32 * wave + q);
        list[list_off(i0) + hist[32 + i0] + p0] = (unsigned short)(qs | (0u << 13));
        if (nsel > 1) list[list_off(i1) + hist[32 + i1] + p1] = (unsigned short)(qs | (1u << 13));
        if (nsel > 2) list[list_off(i2) + hist[32 + i2] + p2] = (unsigned short)(qs | (2u << 13));
    }
    __syncthreads();
}

__device__ __forceinline__ void moba_stage_kv(const Args& a, LAS unsigned char* lds, int b, int h, int n, int tid) {
    const bf16* kg = (const bf16*)(a.ws + WS_BIG) + (size_t)(b * SEQ + n * MBLK) * PMW + O_MK + h * MDH;
    const bf16* vg = (const bf16*)(a.ws + WS_VTG) + (size_t)((b * MH + h) * NBLK + n) * (MDH * MBLK);
    LAS float* TAB = (LAS float*)(lds + AT_TAB);
    if (tid < 129) TAB[tid] = a.in[I_RELB][h * 32 + (tid < 128 ? (int)BUCKET[tid] : 31)] * LOG2E;
    const int wv = __builtin_amdgcn_readfirstlane(tid >> 6), ln = tid & 63;
#pragma unroll
    for (int j = 0; j < 8; ++j) {
        const int g = 8 * j + wv;
        { const int r = 4 * g + (ln >> 4), c = (ln & 15) ^ (r & 15);
          __builtin_amdgcn_global_load_lds((const unsigned*)(kg + (size_t)r * PMW + 8 * c), (LAS unsigned*)(lds + AT_KS + g * 1024), 16, 0, 0); }
        { const int d = 2 * g + (ln >> 5), c = (ln & 31) ^ (d & 15);
          __builtin_amdgcn_global_load_lds((const unsigned*)(vg + (size_t)d * MBLK + 8 * c), (LAS unsigned*)(lds + AT_VT + g * 1024), 16, 0, 0); }
    }
    asm volatile("s_waitcnt vmcnt(0)" ::: "memory");
}
__device__ __forceinline__ void moba_load_q(const Args& a, int b, int h, unsigned e, int hi, bf16x8 (&qf)[8]) {
    const bf16* qp = (const bf16*)(a.ws + WS_BIG) + ((size_t)b * SEQ + (e & 8191u)) * PMW + O_MQ + h * MDH + 8 * hi;
#pragma unroll
    for (int s = 0; s < 8; ++s) qf[s] = *(const bf16x8*)(qp + 16 * s);
}
template <bool OWN>
__device__ __forceinline__ void moba_wave_tile(const Args& a, LAS unsigned char* lds, int b, int h, int n, unsigned e, bf16x8 (&qf)[8], unsigned e_next, bool has_next, int lane, int wave) {
    const int q = lane & 31, hi = lane >> 5;
    const bool valid = (e >> 31) == 0u; const int qpos = (int)(e & 8191u), slot = (int)((e >> 13) & 3u);
    const int xf = OWN ? 0 : a.pad0;
    const bool act = OWN ? true : (__any(valid) != 0 && !(xf & 16));
    const int nst = OWN ? (wave + 1) : 8;
    const LAS float* TAB = (const LAS float*)(lds + AT_TAB);
    const int sw = hi ^ (q & 15);
    float m = -INFINITY, l = 0.f;
    f32x16 o[4];
#pragma unroll
    for (int dt = 0; dt < 4; ++dt)
#pragma unroll
        for (int r = 0; r < 16; ++r) o[dt][r] = 0.f;
    if constexpr (OWN) {
    const LAS unsigned char* kq = lds + AT_KS + q * 256;
    const LAS unsigned char* vq = lds + AT_VT + q * 512;
    int kx[8];
#pragma unroll
    for (int ds = 0; ds < 8; ++ds) kx[ds] = ((2 * ds) ^ sw) << 4;
#define QKT(S, i_) do { const LAS unsigned char* kp_ = kq + (i_) * (32 * 256); \
        _Pragma("unroll") for (int r = 0; r < 16; ++r) S[r] = 0.f; \
        _Pragma("unroll") for (int ds = 0; ds < 8; ++ds) { const bf16x8 kf_ = *(const LAS bf16x8*)(kp_ + kx[ds]); S = mfma32(kf_, qf[ds], S); } } while (0)
#define SOFT(S, i_) do { const int d0_ = qpos - (n * MBLK + 32 * (i_) + 4 * hi);        \
        const bool far_ = !OWN && (__all(d0_ - 27 >= 128) != 0); \
        float alpha_, ps_ = 0.f; \
        if (far_) { const float c_ = TAB[128]; \
            float mr_ = fmaxf(fmaxf(S[0], S[1]), S[2]); \
            _Pragma("unroll") for (int r = 3; r < 16; ++r) mr_ = fmaxf(mr_, S[r]); \
            mr_ = fmaxf(mr_, __shfl_xor(mr_, 32)); \
            const float mn_ = fmaxf(m, mr_ * QK_C1 + c_); alpha_ = __builtin_amdgcn_exp2f(m - mn_); m = mn_; \
            const float cm_ = c_ - mn_; \
            _Pragma("unroll") for (int r = 0; r < 16; ++r) { const float p_ = __builtin_amdgcn_exp2f(__builtin_fmaf(S[r], QK_C1, cm_)); S[r] = p_; ps_ += p_; } \
        } else { \
            _Pragma("unroll") for (int r = 0; r < 16; ++r) { const int dist_ = d0_ - ((r & 3) + 8 * (r >> 2)); \
                const int di_ = dist_ < 0 ? 0 : (dist_ > 128 ? 128 : dist_); \
                const float v_ = S[r] * QK_C1 + TAB[di_]; \
                S[r] = (OWN && dist_ < 0) ? -INFINITY : v_; } \
            float mt_ = S[0]; \
            _Pragma("unroll") for (int r = 1; r < 16; ++r) mt_ = fmaxf(mt_, S[r]); \
            mt_ = fmaxf(mt_, __shfl_xor(mt_, 32)); \
            const float mn_ = fmaxf(m, mt_); alpha_ = __builtin_amdgcn_exp2f(m - mn_); m = mn_; \
            _Pragma("unroll") for (int r = 0; r < 16; ++r) { const float p_ = __builtin_amdgcn_exp2f(S[r] - mn_); S[r] = p_; ps_ += p_; } \
        } \
        l = l * alpha_ + ps_; \
        if (__any(alpha_ != 1.f)) { _Pragma("unroll") for (int dt = 0; dt < 4; ++dt) _Pragma("unroll") for (int r = 0; r < 16; ++r) o[dt][r] *= alpha_; } } while (0)
#define PVT(S, i_) do { _Pragma("unroll") for (int ss = 0; ss < 2; ++ss) { \
            v4u pw_; pw_.x = pk2(S[8 * ss + 0], S[8 * ss + 1]); pw_.y = pk2(S[8 * ss + 2], S[8 * ss + 3]); pw_.z = pk2(S[8 * ss + 4], S[8 * ss + 5]); pw_.w = pk2(S[8 * ss + 6], S[8 * ss + 7]); \
            const bf16x8 pf_ = __builtin_bit_cast(bf16x8, pw_); \
            const int vo_ = ((2 * (2 * (i_) + ss)) ^ sw) << 4;                   \
            _Pragma("unroll") for (int dt = 0; dt < 4; ++dt) { const bf16x8 vf_ = *(const LAS bf16x8*)(vq + dt * (32 * 512) + vo_); o[dt] = mfma32(vf_, pf_, o[dt]); } } } while (0)
    if (act) {
        f32x16 sA, sB;
        QKT(sA, 0);
#pragma unroll 1
        for (int i = 0; i < nst; i += 2) {
            if (i + 1 < nst) QKT(sB, i + 1);
            SOFT(sA, i); PVT(sA, i);
            if (i + 1 < nst) {
                if (i + 2 < nst) QKT(sA, i + 2);
                SOFT(sB, i + 1); PVT(sB, i + 1);
            }
        }
    }
#undef QKT
#undef SOFT
#undef PVT
    } else {
    const LAS unsigned char* kq = lds + AT_KS + q * 256;
    const LAS unsigned char* vq = lds + AT_VT + q * 512;
#define QK64(S, s_) do { const LAS unsigned char* kp_ = kq + (s_) * (64 * 256); \
        _Pragma("unroll") for (int kt = 0; kt < 2; ++kt) { _Pragma("unroll") for (int r = 0; r < 16; ++r) S[kt][r] = 0.f; \
            _Pragma("unroll") for (int ds = 0; ds < 8; ++ds) { const bf16x8 kf_ = *(const LAS bf16x8*)(kp_ + kt * (32 * 256) + (((2 * ds) ^ sw) << 4)); S[kt] = mfma32(kf_, qf[ds], S[kt]); } } } while (0)
#define SOFT64(S, s_) do { const int d0_ = qpos - (n * MBLK + 64 * (s_) + 4 * hi); \
        const bool far_ = (__all(d0_ - 63 >= 128) != 0); \
        float alpha_, ps_ = 0.f; \
        if (far_) { const float c_ = TAB[128]; \
            float mr_ = fmaxf(fmaxf(S[0][0], S[0][1]), S[0][2]); \
            _Pragma("unroll") for (int r = 3; r < 16; ++r) mr_ = fmaxf(mr_, S[0][r]); \
            _Pragma("unroll") for (int r = 0; r < 16; ++r) mr_ = fmaxf(mr_, S[1][r]); \
            mr_ = fmaxf(mr_, __shfl_xor(mr_, 32)); \
            const float mn_ = fmaxf(m, mr_ * QK_C1 + c_); alpha_ = __builtin_amdgcn_exp2f(m - mn_); m = mn_; \
            const float cm_ = c_ - mn_; \
            _Pragma("unroll") for (int kt = 0; kt < 2; ++kt) _Pragma("unroll") for (int r = 0; r < 16; ++r) { const float p_ = __builtin_amdgcn_exp2f(__builtin_fmaf(S[kt][r], QK_C1, cm_)); S[kt][r] = p_; ps_ += p_; } \
        } else { \
            _Pragma("unroll") for (int kt = 0; kt < 2; ++kt) _Pragma("unroll") for (int r = 0; r < 16; ++r) { const int dist_ = d0_ - (32 * kt + (r & 3) + 8 * (r >> 2)); \
                const int di_ = dist_ < 0 ? 0 : (dist_ > 128 ? 128 : dist_); S[kt][r] = S[kt][r] * QK_C1 + TAB[di_]; } \
            float mt_ = S[0][0]; \
            _Pragma("unroll") for (int r = 1; r < 16; ++r) mt_ = fmaxf(mt_, S[0][r]); \
            _Pragma("unroll") for (int r = 0; r < 16; ++r) mt_ = fmaxf(mt_, S[1][r]); \
            mt_ = fmaxf(mt_, __shfl_xor(mt_, 32)); \
            const float mn_ = fmaxf(m, mt_); alpha_ = __builtin_amdgcn_exp2f(m - mn_); m = mn_; \
            _Pragma("unroll") for (int kt = 0; kt < 2; ++kt) _Pragma("unroll") for (int r = 0; r < 16; ++r) { const float p_ = __builtin_amdgcn_exp2f(S[kt][r] - mn_); S[kt][r] = p_; ps_ += p_; } \
        } \
        l = l * alpha_ + ps_; \
        if (__any(alpha_ != 1.f)) { _Pragma("unroll") for (int dt = 0; dt < 4; ++dt) _Pragma("unroll") for (int r = 0; r < 16; ++r) o[dt][r] *= alpha_; } } while (0)
#define PV64(S, s_) do { _Pragma("unroll") for (int j = 0; j < 4; ++j) { \
            v4u pw_; pw_.x = pk2(S[j >> 1][8 * (j & 1) + 0], S[j >> 1][8 * (j & 1) + 1]); pw_.y = pk2(S[j >> 1][8 * (j & 1) + 2], S[j >> 1][8 * (j & 1) + 3]); \
            pw_.z = pk2(S[j >> 1][8 * (j & 1) + 4], S[j >> 1][8 * (j & 1) + 5]); pw_.w = pk2(S[j >> 1][8 * (j & 1) + 6], S[j >> 1][8 * (j & 1) + 7]); \
            const bf16x8 pf_ = __builtin_bit_cast(bf16x8, pw_); \
            const int vo_ = ((8 * (s_) + 2 * j) ^ sw) << 4; \
            _Pragma("unroll") for (int dt = 0; dt < 4; ++dt) { const bf16x8 vf_ = *(const LAS bf16x8*)(vq + dt * (32 * 512) + vo_); o[dt] = mfma32(vf_, pf_, o[dt]); } } } while (0)
    if (act) {
        f32x16 tA[2], tB[2];
        QK64(tA, 0);
#pragma unroll 1
        for (int s = 0; s < 4; s += 2) {
            QK64(tB, s + 1); if (!(xf & 4)) SOFT64(tA, s); PV64(tA, s);
            if (s + 2 < 4) QK64(tA, s + 2);
            if (!(xf & 4)) SOFT64(tB, s + 1); PV64(tB, s + 1);
        }
    }
#undef QK64
#undef SOFT64
#undef PV64
    }
    if (has_next && !(xf & 2)) moba_load_q(a, b, h, e_next, hi, qf);
    if (!act) return;
    const float ltot = l + __shfl_xor(l, 32);
    const size_t tok = (size_t)b * SEQ + qpos;
    const size_t pe0 = (tok * MH + h) * 3;
    bf16* PART = (bf16*)(a.ws + WS_PART); f32x2_t* ML = (f32x2_t*)(a.ws + WS_ML);
    if (!OWN) {
        if (valid && !(xf & 1)) {
            const float inv = 1.f / ltot;
            bf16* pp = PART + (pe0 + slot) * MDH + 8 * hi;
#pragma unroll
            for (int dt = 0; dt < 4; ++dt)
#pragma unroll
                for (int g = 0; g < 4; g += 2) {
                    unsigned ax = pk2(o[dt][4 * g] * inv, o[dt][4 * g + 1] * inv), ay = pk2(o[dt][4 * g + 2] * inv, o[dt][4 * g + 3] * inv);
                    unsigned bx = pk2(o[dt][4 * g + 4] * inv, o[dt][4 * g + 5] * inv), by = pk2(o[dt][4 * g + 6] * inv, o[dt][4 * g + 7] * inv);
                    { auto r = __builtin_amdgcn_permlane32_swap(ax, bx, false, false); ax = r[0]; bx = r[1]; }
                    { auto r = __builtin_amdgcn_permlane32_swap(ay, by, false, false); ay = r[0]; by = r[1]; }
                    *(v4u*)(pp + 32 * dt + 8 * g) = (v4u){ax, ay, bx, by};
                }
            if (hi == 0) ML[pe0 + slot] = (f32x2_t){m, ltot};
        }
    } else {
        const int nsel = n < MTOPK ? n : MTOPK;
        f32x2_t ml0 = {-INFINITY, 0.f}, ml1 = {-INFINITY, 0.f}, ml2 = {-INFINITY, 0.f};
        if (nsel > 0) ml0 = ML[pe0 + 0];
        if (nsel > 1) ml1 = ML[pe0 + 1];
        if (nsel > 2) ml2 = ML[pe0 + 2];
        const float M = fmaxf(fmaxf(m, ml0.x), fmaxf(ml1.x, ml2.x));
        const float wo = __builtin_amdgcn_exp2f(m - M);
        const float w0 = ml0.y * __builtin_amdgcn_exp2f(ml0.x - M), w1 = ml1.y * __builtin_amdgcn_exp2f(ml1.x - M), w2 = ml2.y * __builtin_amdgcn_exp2f(ml2.x - M);
        const float inv = 1.f / (ltot * wo + w0 + w1 + w2);
        const bf16* pp = PART + pe0 * MDH + 8 * hi;
        bf16* op = (bf16*)(a.ws + WS_S) + tok * (MH * MDH) + h * MDH + 8 * hi;
#pragma unroll
        for (int dt = 0; dt < 4; ++dt)
#pragma unroll
            for (int g = 0; g < 4; g += 2) {
                float x[8];
#pragma unroll
                for (int i = 0; i < 8; ++i) x[i] = o[dt][4 * g + i] * wo;
#define MOBA_MERGE(SL, W) do { v4u p = *(const v4u*)(pp + (SL) * MDH + 32 * dt + 8 * g); \
                    { auto r = __builtin_amdgcn_permlane32_swap(p.x, p.z, false, false); p.x = r[0]; p.z = r[1]; } \
                    { auto r = __builtin_amdgcn_permlane32_swap(p.y, p.w, false, false); p.y = r[0]; p.w = r[1]; } \
                    x[0] += (W) * lo_bf(p.x); x[1] += (W) * hi_bf(p.x); x[2] += (W) * lo_bf(p.y); x[3] += (W) * hi_bf(p.y); \
                    x[4] += (W) * lo_bf(p.z); x[5] += (W) * hi_bf(p.z); x[6] += (W) * lo_bf(p.w); x[7] += (W) * hi_bf(p.w); } while (0)
                if (nsel > 0) MOBA_MERGE(0, w0);
                if (nsel > 1) MOBA_MERGE(1, w1);
                if (nsel > 2) MOBA_MERGE(2, w2);
#undef MOBA_MERGE
                unsigned ax = pk2(x[0] * inv, x[1] * inv), ay = pk2(x[2] * inv, x[3] * inv), bx = pk2(x[4] * inv, x[5] * inv), by = pk2(x[6] * inv, x[7] * inv);
                { auto r = __builtin_amdgcn_permlane32_swap(ax, bx, false, false); ax = r[0]; bx = r[1]; }
                { auto r = __builtin_amdgcn_permlane32_swap(ay, by, false, false); ay = r[0]; by = r[1]; }
                *(v4u*)(op + 32 * dt + 8 * g) = (v4u){ax, ay, bx, by};
            }
    }
}

__device__ __forceinline__ void moba_sel_phase(const Args& a, LAS unsigned char* lds, int tid, int lane, int wave, int vcu, int G) {
    LAS unsigned* CNT = (LAS unsigned*)(lds + AT_CNT); LAS unsigned* PRE = (LAS unsigned*)(lds + AT_PRE);
    { const gu32* mc = (const gu32*)(a.ws + WS_CTL) + CW_MCNT; CNT[tid] = __hip_atomic_load(mc + tid, RLX_AGENT); }
    __syncthreads();
    if (wave == 0) {
        unsigned loc = 0;
#pragma unroll
        for (int i = 0; i < 8; ++i) loc += (CNT[lane * 8 + i] + 255u) >> 8;
        unsigned inc = loc;
#pragma unroll
        for (int o = 1; o < 64; o <<= 1) { const unsigned v = __shfl_up(inc, o); if (lane >= o) inc += v; }
        unsigned run = inc - loc;
#pragma unroll
        for (int i = 0; i < 8; ++i) { PRE[lane * 8 + i] = run; run += (CNT[lane * 8 + i] + 255u) >> 8; }
        if (lane == 63) PRE[512] = run;
    }
    __syncthreads();
    const int T = (int)PRE[512];
    const int lo = (int)(((long)vcu * T) / G), hi = (int)(((long)(vcu + 1) * T) / G);
    LAS unsigned* RNG = (LAS unsigned*)(lds + AT_PRE + 516 * 4);
    if (tid == 0) { RNG[0] = 512u; RNG[1] = 0u; }
    __syncthreads();
    { const int s = (int)PRE[tid], nt = (int)((CNT[tid] + 255u) >> 8);
      if (nt > 0 && s < hi && s + nt > lo) { __hip_atomic_fetch_min(&RNG[0], (unsigned)tid, __ATOMIC_RELAXED, __HIP_MEMORY_SCOPE_WORKGROUP); __hip_atomic_fetch_max(&RNG[1], (unsigned)tid + 1u, __ATOMIC_RELAXED, __HIP_MEMORY_SCOPE_WORKGROUP); } }
    __syncthreads();
    const int Lbeg = __builtin_amdgcn_readfirstlane((int)RNG[0]), Lend = __builtin_amdgcn_readfirstlane((int)RNG[1]);
    for (int L = Lbeg; L < Lend; ++L) {
        const int s = (int)PRE[L], cnt = (int)CNT[L], nt = (cnt + 255) >> 8;
        const int t0 = lo > s ? lo - s : 0, t1 = (hi - s) < nt ? (hi - s) : nt;
        if (t0 >= t1) continue;
        const int bh = L >> 5, n = L & 31, b = bh >> 2, h = bh & 3;
        if (!(a.pad0 & 8)) moba_stage_kv(a, lds, b, h, n, tid);
        __syncthreads();
        const unsigned short* list = (const unsigned short*)(a.ws + WS_LIST) + (size_t)bh * LIST_PER_BH + list_off(n);
        {
            const int t0u = __builtin_amdgcn_readfirstlane(t0), t1u = __builtin_amdgcn_readfirstlane(t1), cntu = __builtin_amdgcn_readfirstlane(cnt);
            const int rl = 32 * wave + (lane & 31);
            bf16x8 qf[8];
            unsigned e; { const int ridx = 256 * t0u + rl; e = ridx < cntu ? (unsigned)list[ridx] : 0x80001fffu; }
            moba_load_q(a, b, h, e, lane >> 5, qf);
            for (int t = t0u; t < t1u; ++t) {
                unsigned en = e; const bool hn = t + 1 < t1u;
                if (hn) { const int ridx = 256 * (t + 1) + rl; en = ridx < cntu ? (unsigned)list[ridx] : 0x80001fffu; }
                moba_wave_tile<false>(a, lds, b, h, n, e, qf, en, hn, lane, wave);
                e = en;
            }
        }
        __syncthreads();
    }
}
__device__ __forceinline__ void moba_own_phase(const Args& a, LAS unsigned char* lds, int tid, int lane, int wave, int vcu, int G) {
    for (int u = vcu; u < BATCH * MH * NBLK; u += G) {
        const int bh = u >> 5, n = u & 31, b = bh >> 2, h = bh & 3;
        moba_stage_kv(a, lds, b, h, n, tid);
        __syncthreads();
        { bf16x8 qf[8]; const unsigned e = (unsigned)(n * MBLK + 32 * wave + (lane & 31)); moba_load_q(a, b, h, e, lane >> 5, qf);
          moba_wave_tile<true>(a, lds, b, h, n, e, qf, e, false, lane, wave); }
        __syncthreads();
    }
}

__device__ __forceinline__ void transpose_item(const float* W, int K, int N, bf16* WT, int mode, int thr, int add, LAS float* scr, int item, int lane, int ldt = 0, int koff = 0) {
    if (ldt == 0) ldt = K;
    const int nblk = (N + 31) / 32, kb = item / nblk, nb = item % nblk, k0 = 64 * kb, n0 = 32 * nb;
    const int c4 = 4 * (lane & 7), nc = n0 + c4;
    f32x4 v[8];
#pragma unroll
    for (int i = 0; i < 8; ++i) { const int kk = 8 * i + (lane >> 3); v[i] = nc < N ? *(const f32x4*)(W + (size_t)(k0 + kk) * N + nc) : (f32x4){0.f, 0.f, 0.f, 0.f}; }
#pragma unroll
    for (int i = 0; i < 8; ++i) { const int kk = 8 * i + (lane >> 3); LAS float* s = scr + kk * 33 + c4; s[0] = v[i][0]; s[1] = v[i][1]; s[2] = v[i][2]; s[3] = v[i][3]; }
    LDS_WAIT(); asm volatile("" ::: "memory");
    const int c = lane & 7;
#pragma unroll
    for (int j = 0; j < 4; ++j) { const int nl = (lane >> 3) + 8 * j, n = n0 + nl; const LAS float* s = scr + (8 * c) * 33 + nl;
        v4u o; o.x = pk2(s[0 * 33], s[1 * 33]); o.y = pk2(s[2 * 33], s[3 * 33]); o.z = pk2(s[4 * 33], s[5 * 33]); o.w = pk2(s[6 * 33], s[7 * 33]);
        const int drow = mode == 0 ? (n + (n >= thr ? add : 0)) : mode == 1 ? (256 * (n >> 7) + (n & 127) + add)
                       : (n < S_GLR ? n : n < S_GOG ? -1 : n < S_GA ? n - (S_GOG - S_GLR) : n - S_GA + PMN);
        if (n < N && drow >= 0) *(GAS v4u*)(WT + (size_t)drow * ldt + koff + k0 + 8 * c) = o; }
    LDS_WAIT(); asm volatile("" ::: "memory");
}

__device__ __forceinline__ void phase_p0(const Args& a, LAS unsigned char* lds, int tid, int lane, int wave, int vcu, int G) {
    unsigned char* ws = a.ws;
    float* mod = (float*)(ws + WS_MOD);
    for (int item = vcu; item < (NMOD * D) / 64; item += G) {
        LAS float* sc = (LAS float*)lds;
        for (int i = tid; i < BATCH * D; i += NWAVES * 64) sc[i] = silu_f(a.in[I_C][i]);
        __syncthreads();
        const int j = item * 64 + lane;
        float acc0 = 0.f, acc1 = 0.f, acc2 = 0.f, acc3 = 0.f;
        const float* wp = a.in[I_WADA] + (size_t)(wave * 128) * (NMOD * D) + j;
#pragma unroll 32
        for (int k = 0; k < 128; ++k) { const float w = wp[(size_t)k * (NMOD * D)]; const int kk = wave * 128 + k;
            acc0 += sc[kk] * w; acc1 += sc[D + kk] * w; acc2 += sc[2 * D + kk] * w; acc3 += sc[3 * D + kk] * w; }
        LAS float* red = (LAS float*)(lds + 16384);
        red[(wave * 4 + 0) * 64 + lane] = acc0; red[(wave * 4 + 1) * 64 + lane] = acc1; red[(wave * 4 + 2) * 64 + lane] = acc2; red[(wave * 4 + 3) * 64 + lane] = acc3;
        __syncthreads();
        if (wave < 4) { float s = 0.f;
#pragma unroll
            for (int w = 0; w < NWAVES; ++w) s += red[(w * 4 + wave) * 64 + lane];
            mod[wave * (NMOD * D) + j] = s + a.in[I_BADA][j]; }
        __syncthreads();
    }
    LAS float* scr = (LAS float*)(lds + RING_OFF + wave * 16384);
    const int gw = vcu * NWAVES + wave, NGW = G * NWAVES;
    constexpr int I_FU = (D / 64) * (FF / 32), I_FD = (FF / 64) * (D / 32), I_IN = (D / 64) * ((INW + 31) / 32), I_BR = (512 / 64) * (D / 32), I_OUT = (D / 64) * (D / 32);
    constexpr int NITEMS = 2 * I_FU + I_FD + I_IN + 2 * I_BR + I_OUT;
    for (int it = gw; it < NITEMS; it += NGW) {
        int r = it;
        if (r < I_FU) { transpose_item(a.in[I_W1G], D, FF, (bf16*)(ws + WS_W1GU), 1, 0, 0, scr, r, lane); continue; } r -= I_FU;
        if (r < I_FU) { transpose_item(a.in[I_W1U], D, FF, (bf16*)(ws + WS_W1GU), 1, 0, 128, scr, r, lane); continue; } r -= I_FU;
        if (r < I_FD) { transpose_item(a.in[I_W1D], FF, D, (bf16*)(ws + WS_W1D), 0, 1 << 30, 0, scr, r, lane); continue; } r -= I_FD;
        if (r < I_IN) { transpose_item(a.in[I_WIN], D, INW, (bf16*)(ws + WS_WIN), 2, 0, 0, scr, r, lane); continue; } r -= I_IN;
        if (r < I_BR) { transpose_item(a.in[I_WBRA], 512, D, (bf16*)(ws + WS_WBRA), 0, 1 << 30, 0, scr, r, lane, D, 0); continue; } r -= I_BR;
        if (r < I_BR) { transpose_item(a.in[I_WBRB], 512, D, (bf16*)(ws + WS_WBRA), 0, 1 << 30, 0, scr, r, lane, D, 512); continue; } r -= I_BR;
        transpose_item(a.in[I_WOUT], D, D, (bf16*)(ws + WS_WOUT), 0, 1 << 30, 0, scr, r, lane);
    }
    for (int it = gw * 64 + lane; it < (GH * GDK) * (D / 8); it += NGW * 64) {
        const int j = it >> 7, k0 = (it & 127) * 8;
        float wl[16];
#pragma unroll
        for (int r = 0; r < 16; ++r) wl[r] = a.in[I_WLR][r * (GH * GDK) + j];
        float o[8];
#pragma unroll
        for (int kk = 0; kk < 8; ++kk) { const float* p = a.in[I_WIN] + (size_t)(k0 + kk) * INW + S_GLR;
            const f32x4 x0 = *(const f32x4*)p, x1 = *(const f32x4*)(p + 4), x2 = *(const f32x4*)(p + 8), x3 = *(const f32x4*)(p + 12);
            o[kk] = ((x0[0] * wl[0] + x0[1] * wl[1]) + (x0[2] * wl[2] + x0[3] * wl[3])) + ((x1[0] * wl[4] + x1[1] * wl[5]) + (x1[2] * wl[6] + x1[3] * wl[7]))
                  + ((x2[0] * wl[8] + x2[1] * wl[9]) + (x2[2] * wl[10] + x2[3] * wl[11])) + ((x3[0] * wl[12] + x3[1] * wl[13]) + (x3[2] * wl[14] + x3[3] * wl[15])); }
        v4u w; w.x = pk2(o[0], o[1]); w.y = pk2(o[2], o[3]); w.z = pk2(o[4], o[5]); w.w = pk2(o[6], o[7]);
        *(GAS v4u*)((bf16*)(ws + WS_WIN) + (size_t)(O_Z + j) * D + k0) = w;
    }
}

__device__ __forceinline__ void convert_ffn2(const Args& a, LAS unsigned char* lds, int lane, int wave, int vi, int nv) {
    unsigned char* ws = a.ws;
    LAS float* scr = (LAS float*)(lds + RING_OFF + wave * 16384);
    constexpr int I_FU = (D / 64) * (FF / 32), I_FD = (FF / 64) * (D / 32);
    for (int it = vi * NWAVES + wave; it < 2 * I_FU + I_FD; it += nv * NWAVES) {
        int r = it;
        if (r < I_FU) { transpose_item(a.in[I_W2G], D, FF, (bf16*)(ws + WS_W2GU), 1, 0, 0, scr, r, lane); continue; } r -= I_FU;
        if (r < I_FU) { transpose_item(a.in[I_W2U], D, FF, (bf16*)(ws + WS_W2GU), 1, 0, 128, scr, r, lane); continue; } r -= I_FU;
        transpose_item(a.in[I_W2D], FF, D, (bf16*)(ws + WS_W2D), 0, 1 << 30, 0, scr, r, lane);
    }
}

__device__ __forceinline__ void phase_norm_mod(const float* h, const float* g, const float* mod_sh, const float* mod_sc, bf16* u, int lane, int wave, int vcu, int G) {
    const int gw = vcu * NWAVES + wave, NGW = G * NWAVES, rpw = 16;
    for (int r0 = gw * rpw; r0 < MTOK; r0 += NGW * rpw) {
    const int b = r0 / SEQ;
    f32x4 cs[4], sh[4];
#pragma unroll
    for (int j = 0; j < 4; ++j) { const int c = 4 * (lane + 64 * j);
        const f32x4 gg = *(const f32x4*)(g + c), s = *(const f32x4*)(mod_sc + (size_t)b * (NMOD * D) + c);
        cs[j] = gg * (s + 1.0f); sh[j] = *(const f32x4*)(mod_sh + (size_t)b * (NMOD * D) + c); }
    for (int r = r0; r < r0 + rpw; ++r) {
        const GAS f32x4* xr = (const GAS f32x4*)(h + (size_t)r * D) + lane;
        f32x4 v[4]; float s = 0.f;
#pragma unroll
        for (int j = 0; j < 4; ++j) { v[j] = xr[64 * j]; s += (v[j].x * v[j].x + v[j].y * v[j].y) + (v[j].z * v[j].z + v[j].w * v[j].w); }
        const float rstd = rsqrtf(wave_sum(s) * (1.f / D) + EPS);
        GAS v2u* o8 = (GAS v2u*)(u + (size_t)r * D) + lane;
#pragma unroll
        for (int j = 0; j < 4; ++j) { const f32x4 y = v[j] * rstd * cs[j] + sh[j]; v2u w; w.x = pk2(y.x, y.y); w.y = pk2(y.z, y.w); o8[64 * j] = w; }
    }
    }
}
__device__ __forceinline__ void row16_bf(const bf16* p, int lane, float (&v)[16]) {
    const v4u a = *(const v4u*)(p + 8 * lane), c = *(const v4u*)(p + 512 + 8 * lane);
    v[0] = lo_bf(a.x); v[1] = hi_bf(a.x); v[2] = lo_bf(a.y); v[3] = hi_bf(a.y); v[4] = lo_bf(a.z); v[5] = hi_bf(a.z); v[6] = lo_bf(a.w); v[7] = hi_bf(a.w);
    v[8] = lo_bf(c.x); v[9] = hi_bf(c.x); v[10] = lo_bf(c.y); v[11] = hi_bf(c.y); v[12] = lo_bf(c.z); v[13] = hi_bf(c.z); v[14] = lo_bf(c.w); v[15] = hi_bf(c.w);
}
__device__ __forceinline__ void vec16_f(const float* p, int lane, float (&v)[16]) {
#pragma unroll
    for (int j = 0; j < 2; ++j) { const f32x4 a = *(const f32x4*)(p + 512 * j + 8 * lane), c = *(const f32x4*)(p + 512 * j + 8 * lane + 4);
        v[8 * j] = a[0]; v[8 * j + 1] = a[1]; v[8 * j + 2] = a[2]; v[8 * j + 3] = a[3]; v[8 * j + 4] = c[0]; v[8 * j + 5] = c[1]; v[8 * j + 6] = c[2]; v[8 * j + 7] = c[3]; }
}
__device__ __forceinline__ void phase_norm_mod_b(const bf16* h, const float* g, const float* mod_sh, const float* mod_sc, bf16* u, int lane, int wave, int vcu, int G) {
    const int gw = vcu * NWAVES + wave, NGW = G * NWAVES, rpw = 16;
    for (int r0 = gw * rpw; r0 < MTOK; r0 += NGW * rpw) {
    const int b = r0 / SEQ;
    float cs[16], sh[16];
    { float gg[16], ss[16]; vec16_f(g, lane, gg); vec16_f(mod_sc + (size_t)b * (NMOD * D), lane, ss); vec16_f(mod_sh + (size_t)b * (NMOD * D), lane, sh);
#pragma unroll
      for (int i = 0; i < 16; ++i) cs[i] = gg[i] * (ss[i] + 1.0f); }
    for (int r = r0; r < r0 + rpw; ++r) {
        float v[16]; row16_bf(h + (size_t)r * D, lane, v);
        float s = 0.f;
#pragma unroll
        for (int i = 0; i < 16; ++i) s += v[i] * v[i];
        const float rstd = rsqrtf(wave_sum(s) * (1.f / D) + EPS);
#pragma unroll
        for (int j = 0; j < 2; ++j) { v4u w;
            w.x = pk2(v[8 * j] * rstd * cs[8 * j] + sh[8 * j], v[8 * j + 1] * rstd * cs[8 * j + 1] + sh[8 * j + 1]); w.y = pk2(v[8 * j + 2] * rstd * cs[8 * j + 2] + sh[8 * j + 2], v[8 * j + 3] * rstd * cs[8 * j + 3] + sh[8 * j + 3]);
            w.z = pk2(v[8 * j + 4] * rstd * cs[8 * j + 4] + sh[8 * j + 4], v[8 * j + 5] * rstd * cs[8 * j + 5] + sh[8 * j + 5]); w.w = pk2(v[8 * j + 6] * rstd * cs[8 * j + 6] + sh[8 * j + 6], v[8 * j + 7] * rstd * cs[8 * j + 7] + sh[8 * j + 7]);
            *(v4u*)(u + (size_t)r * D + 512 * j + 8 * lane) = w; }
    }
    }
}
__device__ __forceinline__ void phase_final_norm(const bf16* h, float* out, const float* g, int lane, int wave, int vcu, int G) {
    const int gw = vcu * NWAVES + wave, NGW = G * NWAVES, rpw = 16;
    float cs[16]; vec16_f(g, lane, cs);
    for (int r0 = gw * rpw; r0 < MTOK; r0 += NGW * rpw)
    for (int r = r0; r < r0 + rpw; ++r) {
        float v[16]; row16_bf(h + (size_t)r * D, lane, v);
        float s = 0.f;
#pragma unroll
        for (int i = 0; i < 16; ++i) s += v[i] * v[i];
        const float rstd = rsqrtf(wave_sum(s) * (1.f / D) + EPS);
#pragma unroll
        for (int j = 0; j < 2; ++j) { float* o = out + (size_t)r * D + 512 * j + 8 * lane;
            *(f32x4*)o = (f32x4){v[8 * j] * rstd * cs[8 * j], v[8 * j + 1] * rstd * cs[8 * j + 1], v[8 * j + 2] * rstd * cs[8 * j + 2], v[8 * j + 3] * rstd * cs[8 * j + 3]};
            *(f32x4*)(o + 4) = (f32x4){v[8 * j + 4] * rstd * cs[8 * j + 4], v[8 * j + 5] * rstd * cs[8 * j + 5], v[8 * j + 6] * rstd * cs[8 * j + 6], v[8 * j + 7] * rstd * cs[8 * j + 7]}; }
    }
}

constexpr int NPHASE = 17;
__global__ void __launch_bounds__(NWAVES * 64, 2) mega_fwd(Args args) {
    extern __shared__ __attribute__((aligned(16))) unsigned char lds_raw[];
    LAS unsigned char* lds = (LAS unsigned char*)lds_raw;
    volatile LAS unsigned* MISC = (volatile LAS unsigned*)(lds + MISC_OFF);
    const int wave = __builtin_amdgcn_readfirstlane((int)threadIdx.x >> 6);
    int lane = (int)threadIdx.x & 63, tid = (int)threadIdx.x;
#define REFRESH_IDS() (lane = (int)__builtin_amdgcn_mbcnt_hi(~0u, __builtin_amdgcn_mbcnt_lo(~0u, 0u)), tid = wave * 64 + lane, true)
    const int G = gridDim.x; const int bx = blockIdx.x; const int vcu = (G % 8 == 0) ? (bx % 8) * (G / 8) + bx / 8 : bx;
    unsigned char* ws = args.ws;
    gu32* ctl = (gu32*)(ws + WS_CTL);
    for (int u = tid; u < (LDS_BYTES - LDSCTL_OFF) / 4; u += NWAVES * 64) ((LAS unsigned*)(lds + LDSCTL_OFF))[u] = 0u;
    __syncthreads();
    XcdBarrier bar = xcd_barrier_post((unsigned*)(ctl + CW_BAR) + args.li * XCD_BAR_WORDS, MISC + 8);
    const unsigned pmask = (unsigned)args.ph_mask;
#define IN(k) ((pmask >> (k)) & 1u)
#define SEAM(k) do { if (IN(k) && (pmask >> ((k) + 1)) != 0u) xcd_barrier(bar); } while (0)
    float* mod = (float*)(ws + WS_MOD);
    bf16* U = (bf16*)(ws + WS_U); bf16* BIG = (bf16*)(ws + WS_BIG); bf16* MERGED = (bf16*)(ws + WS_PART);
    bf16* OA = (bf16*)(ws + WS_OA); bf16* OB = (bf16*)(ws + WS_S);
    bf16* HB = args.li ? (bf16*)(ws + WS_PART) : (bf16*)args.out;
    float* OUT = args.li ? (float*)(ws + WS_PART) : args.out;
    unsigned char* G8 = (args.li ? (unsigned char*)(ws + WS_PART) : (unsigned char*)args.out) + (size_t)MTOK * D * 2;

#define PH(k) if (IN(k) && ((ONLYMASK >> (k)) & 1) && REFRESH_IDS())

    PH(0) phase_p0(args, lds, tid, lane, wave, vcu, G);
    SEAM(0);
    PH(1) phase_norm_mod(args.in[I_X], args.in[I_NFF1], mod + 0 * D, mod + 1 * D, U, lane, wave, vcu, G);
    SEAM(1);
    PH(2) { pg8::Gemm g{U, (const bf16*)(ws + WS_W1GU), MTOK, 2 * FF, D}; pg8::StaticOrder S; S.init(MTOK, 2 * FF, G, bx);
        pg8::EpiSwiGLU E{BIG, FF, 0}; pg8::gemm_phase<pg8::EpiSwiGLU, pg8::StaticOrder, true, true>(lds + RING_OFF, g, S, E, tid); }
    SEAM(2);
    PH(3) { pg8::Gemm g{BIG, (const bf16*)(ws + WS_W1D), MTOK, D, FF}; pg8::StaticOrder S; S.init(MTOK, D, G, bx);
        pg8::EpiResid<false> E{args.in[I_X], HB, mod + 2 * D, 0.5f}; pg8::gemm_phase<pg8::EpiResid<false>, pg8::StaticOrder, true, true>(lds + RING_OFF, g, S, E, tid); }
    SEAM(3);
    PH(4) phase_norm_mod_b(HB, args.in[I_NMIX], mod + 3 * D, mod + 4 * D, U, lane, wave, vcu, G);
    SEAM(4);
    PH(5) { pg8::Gemm g{U, (const bf16*)(ws + WS_WIN), MTOK, PJN, D}; pg8::StaticOrder S; S.init(MTOK, PJN, G, bx);
        pg8::EpiProj E{BIG, G8, args.in[I_BLR]}; pg8::gemm_phase<pg8::EpiProj, pg8::StaticOrder, true, true>(lds + RING_OFF, g, S, E, tid);
        { const int nwg = (MTOK / 256) * (PJN / 256), rem = nwg % G;
          if (rem == 0) convert_ffn2(args, lds, lane, wave, bx, G); else if (bx >= rem) convert_ffn2(args, lds, lane, wave, bx - rem, G - rem); } }
    SEAM(5);
    PH(6) { if (args.li != 3) gla_local_phase(args, lds, tid, lane, wave, vcu, G);
        if (args.li != 4) for (int u = vcu; u < BATCH * MH * NBLK; u += G) moba_prep_unit(args, lds, u, tid); }
    SEAM(6);
    PH(7) { if (args.li != 3 && tid < 256) for (int gt = vcu * 256 + tid; gt < 65536; gt += G * 256) gla_scan(args, gt);
        if (args.li != 4) for (int u = vcu; u < BATCH * MH * (NBLK - 1); u += G) moba_topk_unit(args, lds, u, tid); }
    SEAM(7);
    PH(8) {
#ifndef NO_GLA_OUT
        if (args.li != 3) gla_out_phase(args, lds, tid, lane, wave, vcu, G);
#endif
#ifndef NO_SEL
        if (args.li != 4) moba_sel_phase(args, lds, tid, lane, wave, vcu, G);
#endif
    }
    SEAM(8);
    PH(9) moba_own_phase(args, lds, tid, lane, wave, vcu, G);
    SEAM(9);
    SEAM(10);
    PH(11) { pg8::Gemm g{OA, (const bf16*)(ws + WS_WBRA), MTOK, D, D, OB, 512, 8}; pg8::StaticOrder S; S.init(MTOK, D, G, bx);
        pg8::EpiGateCat E{MERGED, G8}; pg8::gemm_phase<pg8::EpiGateCat, pg8::StaticOrder, true, true>(lds + RING_OFF, g, S, E, tid); }
    SEAM(11);
    PH(12) { pg8::Gemm g{MERGED, (const bf16*)(ws + WS_WOUT), MTOK, D, D}; pg8::StaticOrder S; S.init(MTOK, D, G, bx);
        pg8::EpiResid<true> E{HB, HB, mod + 5 * D, 1.0f}; pg8::gemm_phase<pg8::EpiResid<true>, pg8::StaticOrder, true, true>(lds + RING_OFF, g, S, E, tid); }
    SEAM(12);
    PH(13) phase_norm_mod_b(HB, args.in[I_NFF2], mod + 6 * D, mod + 7 * D, U, lane, wave, vcu, G);
    SEAM(13);
    PH(14) { pg8::Gemm g{U, (const bf16*)(ws + WS_W2GU), MTOK, 2 * FF, D}; pg8::StaticOrder S; S.init(MTOK, 2 * FF, G, bx);
        pg8::EpiSwiGLU E{BIG, FF, 0}; pg8::gemm_phase<pg8::EpiSwiGLU, pg8::StaticOrder, true, true>(lds + RING_OFF, g, S, E, tid); }
    SEAM(14);
    PH(15) { pg8::Gemm g{BIG, (const bf16*)(ws + WS_W2D), MTOK, D, FF}; pg8::StaticOrder S; S.init(MTOK, D, G, bx);
        pg8::EpiResid<true> E{HB, U, mod + 8 * D, 0.5f}; pg8::gemm_phase<pg8::EpiResid<true>, pg8::StaticOrder, true, true>(lds + RING_OFF, g, S, E, tid); }
    SEAM(15);
    PH(16) phase_final_norm(U, OUT, args.in[I_NFIN], lane, wave, vcu, G);
    SEAM(17); SEAM(18); SEAM(19); SEAM(20); SEAM(21); SEAM(22); SEAM(23); SEAM(24);
#undef IN
#undef PH
#undef SEAM
}

extern "C" void kernel_launch(void* const* d_in, const int* in_sizes, int n_in, void* d_out, int out_size, void* d_ws, size_t ws_size, hipStream_t stream) {
    static int grid = 0;
    if (grid == 0) {
        if (n_in != 22 || out_size != MTOK * D || ws_size < WS_END) { fprintf(stderr, "kernel_launch: unexpected problem (n_in %d out %d ws %zu)\n", n_in, out_size, ws_size); grid = -1; return; }
        int dev = 0, cus = 0;
        if (hipGetDevice(&dev) != hipSuccess || hipDeviceGetAttribute(&cus, hipDeviceAttributeMultiprocessorCount, dev) != hipSuccess) { grid = -1; return; }
        if (hipFuncSetAttribute((const void*)mega_fwd, hipFuncAttributeMaxDynamicSharedMemorySize, LDS_BYTES) != hipSuccess) { grid = -1; return; }
        grid = cus;
    }
    if (grid < 0) return;
    (void)hipMemsetAsync((char*)d_ws + WS_CTL, 0, CTL_ZERO_BYTES, stream);
    Args a{};
    for (int i = 0; i < 22; ++i) a.in[i] = (const float*)d_in[i];
    a.out = (float*)d_out; a.ws = (unsigned char*)d_ws;
    unsigned char* ws = (unsigned char*)d_ws;
    a.ph_mask = ((1 << NPHASE) - 1) & ~(1 << 10); a.li = 0;
    hipLaunchKernelGGL(mega_fwd, dim3(grid), dim3(NWAVES * 64), LDS_BYTES, stream, a);
#if PROBEMASK
    a.ph_mask = PROBEMASK; a.li = PROBELI; a.pad0 = PROBEX;
    hipLaunchKernelGGL(mega_fwd, dim3(grid), dim3(NWAVES * 64), LDS_BYTES, stream, a);
#endif
}
```
